# Optimizing an MI355X kernel written in HIP

```python
import jax, jax.numpy as jnp
from jax import lax
import numpy as np

D_MODEL = 1024
BATCH = 32
SEQ = 256
DEPTH = 4
DEC_BATCH = 4
DEC_SEQ = 1024
PAST_LEN = 512

GRID_W = 64
N_MIXERS = 3
N_A = (DEPTH + 2) // 3
N_B = (DEPTH + 1) // 3
N_C = DEPTH // 3
BRANCH = D_MODEL
HEAD_DIM = 64
N_HEADS = BRANCH // HEAD_DIM
KV_HEADS = 4
GROUPS = N_HEADS // KV_HEADS
MLA_Q_LORA = 384
MLA_KV_LORA = 256
MLA_NOPE = 64
MLA_ROPE = 32
MLA_V = HEAD_DIM
WINDOW = 128
Q_BLOCK = 128
ROPE_THETA = 10000.0
EPS = 1e-6
NEG_INF = -1e30
MLA_IN = MLA_Q_LORA + MLA_KV_LORA + MLA_ROPE + BRANCH
GQA_IN = N_HEADS * HEAD_DIM + 2 * KV_HEADS * HEAD_DIM + BRANCH

kernel_name = "hybrid_diffusion_prefix_mla_gqa_swa_step"

F32 = jnp.float32


def rms_norm(x, g):
    xf = x.astype(F32)
    y = xf * lax.rsqrt(jnp.mean(xf * xf, axis=-1, keepdims=True) + EPS)
    return (y * g.astype(F32)).astype(x.dtype)


def adaln(cvec, w, b):
    m = jax.nn.silu(cvec) @ w + b
    return jnp.split(m, 3, axis=-1)


def mod_norm(x, g, shift, scale):
    return rms_norm(x, g) * (1.0 + scale) + shift


def axial_rope(T, rot_dim):
    rows = T // GRID_W
    row = jnp.repeat(jnp.arange(rows), GRID_W).astype(F32)
    col = jnp.tile(jnp.arange(GRID_W), rows).astype(F32)
    nf = rot_dim // 4
    freqs = ROPE_THETA ** (-jnp.arange(nf, dtype=F32) / nf)
    ang = jnp.concatenate([row[:, None] * freqs, col[:, None] * freqs], axis=-1)
    return jnp.cos(ang), jnp.sin(ang)


def rope_2d(x, cos, sin):
    xp = x.reshape(x.shape[:-1] + (x.shape[-1] // 2, 2)).astype(F32)
    a, b = xp[..., 0], xp[..., 1]
    shp = (cos.shape[0],) + (1,) * (x.ndim - 3) + (cos.shape[1],)
    c, s = cos.reshape(shp), sin.reshape(shp)
    out = jnp.stack([a * c - b * s, a * s + b * c], axis=-1).reshape(x.shape)
    return out.astype(x.dtype)


def sweep_queries(attend, qs):
    B, T = qs[0].shape[:2]
    nb = T // Q_BLOCK
    blocks = tuple(jnp.moveaxis(q.reshape((B, nb, Q_BLOCK) + q.shape[2:]), 1, 0) for q in qs)
    out = lax.map(lambda xs: attend(*xs), blocks)
    out = jnp.moveaxis(out, 0, 1)
    return out.reshape((B, T) + out.shape[3:])


def mla_project(h, w_in, q_norm, w_uq, kv_norm):
    B, T, _ = h.shape
    z = h @ w_in
    cq, ckv, kpe, gate = jnp.split(z, [MLA_Q_LORA, MLA_Q_LORA + MLA_KV_LORA,
                                       MLA_Q_LORA + MLA_KV_LORA + MLA_ROPE], axis=-1)
    q = (rms_norm(cq, q_norm) @ w_uq).reshape(B, T, N_HEADS, MLA_NOPE + MLA_ROPE)
    return q[..., :MLA_NOPE], q[..., MLA_NOPE:], rms_norm(ckv, kv_norm), kpe, gate


def mla_expand(ckv, w_ukv):
    B, L, _ = ckv.shape
    kv = (ckv @ w_ukv).reshape(B, L, N_HEADS, MLA_NOPE + MLA_V)
    return kv[..., :MLA_NOPE], kv[..., MLA_NOPE:]


def mla_attend(q_nope, q_rope, k_nope, k_rope, v):
    scale = (MLA_NOPE + MLA_ROPE) ** -0.5

    def attend(qn, qr):
        s = (jnp.einsum('bqhd,bkhd->bhqk', qn, k_nope, preferred_element_type=F32)
             + jnp.einsum('bqhr,bkr->bhqk', qr, k_rope, preferred_element_type=F32)) * scale
        p = jax.nn.softmax(s, axis=-1)
        return jnp.einsum('bhqk,bkhd->bqhd', p.astype(v.dtype), v)

    return sweep_queries(attend, (q_nope, q_rope))


def gqa_project(h, w_in):
    B, T, _ = h.shape
    z = h @ w_in
    nq, nk = N_HEADS * HEAD_DIM, KV_HEADS * HEAD_DIM
    q, k, v, gate = jnp.split(z, [nq, nq + nk, nq + 2 * nk], axis=-1)
    return (q.reshape(B, T, KV_HEADS, GROUPS, HEAD_DIM), k.reshape(B, T, KV_HEADS, HEAD_DIM),
            v.reshape(B, T, KV_HEADS, HEAD_DIM), gate)


def gqa_dense(q, k, v, sink=None):
    scale = HEAD_DIM ** -0.5

    def attend(qb):
        s = jnp.einsum('bqhgd,bkhd->bhgqk', qb, k, preferred_element_type=F32) * scale
        if sink is not None:
            sb = jnp.broadcast_to(sink.reshape(KV_HEADS, GROUPS, 1, 1).astype(F32), s.shape[:-1] + (1,))
            p = jax.nn.softmax(jnp.concatenate([s, sb], axis=-1), axis=-1)[..., :-1]
        else:
            p = jax.nn.softmax(s, axis=-1)
        return jnp.einsum('bhgqk,bkhd->bqhgd', p.astype(v.dtype), v)

    return sweep_queries(attend, (q,))


def swa_latent(q, k, v, k_ctx, v_ctx, sink):
    B, T = q.shape[:2]
    nb = T // Q_BLOCK
    Lc = k_ctx.shape[1]
    scale = HEAD_DIM ** -0.5

    def band(x):
        xp = jnp.pad(x, ((0, 0), (Q_BLOCK, Q_BLOCK), (0, 0), (0, 0)))
        xp = xp.reshape((B, nb + 2, Q_BLOCK) + x.shape[2:])
        xw = jnp.concatenate([xp[:, :-2], xp[:, 1:-1], xp[:, 2:]], axis=2)
        return jnp.moveaxis(xw, 1, 0)

    qb = jnp.moveaxis(q.reshape((B, nb, Q_BLOCK) + q.shape[2:]), 1, 0)
    qi = jnp.arange(Q_BLOCK)[:, None]
    kj = jnp.arange(3 * Q_BLOCK)[None, :]
    kpos = jnp.arange(nb)[:, None, None] * Q_BLOCK - Q_BLOCK + kj[None]
    valid = (jnp.abs(kj - Q_BLOCK - qi) <= WINDOW)[None] & (kpos >= 0) & (kpos < T)
    sink_b = sink.reshape(KV_HEADS, GROUPS, 1, 1).astype(F32)

    def attend(xs):
        qn, kw, vw, m = xs
        s_ctx = jnp.einsum('bqhgd,bkhd->bhgqk', qn, k_ctx, preferred_element_type=F32) * scale
        s_loc = jnp.einsum('bqhgd,bkhd->bhgqk', qn, kw, preferred_element_type=F32) * scale
        s_loc = jnp.where(m, s_loc, NEG_INF)
        s_sink = jnp.broadcast_to(sink_b, s_ctx.shape[:-1] + (1,))
        p = jax.nn.softmax(jnp.concatenate([s_ctx, s_loc, s_sink], axis=-1), axis=-1).astype(v.dtype)
        return (jnp.einsum('bhgqk,bkhd->bqhgd', p[..., :Lc], v_ctx)
                + jnp.einsum('bhgqk,bkhd->bqhgd', p[..., Lc:-1], vw))

    out = lax.map(attend, (qb, band(k), band(v), valid))
    out = jnp.moveaxis(out, 0, 1)
    return out.reshape((B, T) + out.shape[3:])


def finish(o, gate, w_out):
    B, T = o.shape[:2]
    return (o.reshape(B, T, BRANCH) * jax.nn.silu(gate)) @ w_out


def setup_inputs(seed: int = 0) -> dict:
    key = jax.random.key(seed)
    ks = jax.random.split(key, 26)
    nrm = jax.random.normal
    D = D_MODEL
    return {
        "x_prompt": nrm(ks[0], (BATCH, SEQ, D), F32),
        "x_sample": nrm(ks[1], (DEC_BATCH, DEC_SEQ, D), F32),
        "cache_mla_ckv": nrm(ks[2], (DEC_BATCH, N_A, PAST_LEN, MLA_KV_LORA), F32),
        "cache_mla_kpe": nrm(ks[3], (DEC_BATCH, N_A, PAST_LEN, MLA_ROPE), F32),
        "cache_gqa_k": nrm(ks[4], (DEC_BATCH, N_B, PAST_LEN, KV_HEADS, HEAD_DIM), F32),
        "cache_gqa_v": nrm(ks[5], (DEC_BATCH, N_B, PAST_LEN, KV_HEADS, HEAD_DIM), F32),
        "cache_swa_k": nrm(ks[6], (DEC_BATCH, N_C, PAST_LEN, KV_HEADS, HEAD_DIM), F32),
        "cache_swa_v": nrm(ks[7], (DEC_BATCH, N_C, PAST_LEN, KV_HEADS, HEAD_DIM), F32),
        "c": nrm(ks[8], (DEC_BATCH, D), F32),
        "c_ctx": nrm(ks[9], (D,), F32),
        "norm_g": 1.0 + 0.1 * nrm(ks[10], (DEPTH, D), F32),
        "w_ada": 0.5 * D ** -0.5 * nrm(ks[11], (DEPTH, D, 3 * D), F32),
        "b_ada": 0.01 * nrm(ks[12], (DEPTH, 3 * D), F32),
        "w_out": BRANCH ** -0.5 * nrm(ks[13], (DEPTH, BRANCH, D), F32),
        "mla_w_in": D ** -0.5 * nrm(ks[14], (N_A, D, MLA_IN), F32),
        "mla_q_norm": 1.0 + 0.1 * nrm(ks[15], (N_A, MLA_Q_LORA), F32),
        "mla_w_uq": MLA_Q_LORA ** -0.5 * nrm(ks[16], (N_A, MLA_Q_LORA, N_HEADS * (MLA_NOPE + MLA_ROPE)), F32),
        "mla_kv_norm": 1.0 + 0.1 * nrm(ks[17], (N_A, MLA_KV_LORA), F32),
        "mla_w_ukv": MLA_KV_LORA ** -0.5 * nrm(ks[18], (N_A, MLA_KV_LORA, N_HEADS * (MLA_NOPE + MLA_V)), F32),
        "gqa_w_in": D ** -0.5 * nrm(ks[19], (N_B, D, GQA_IN), F32),
        "gqa_q_norm": 1.0 + 0.1 * nrm(ks[20], (N_B, HEAD_DIM), F32),
        "gqa_k_norm": 1.0 + 0.1 * nrm(ks[21], (N_B, HEAD_DIM), F32),
        "swa_w_in": D ** -0.5 * nrm(ks[22], (N_C, D, GQA_IN), F32),
        "swa_sink": nrm(ks[23], (N_C, N_HEADS), F32),
        "final_norm_g": 1.0 + 0.1 * nrm(ks[24], (D,), F32),
    }


def reference(x_prompt, x_sample, cache_mla_ckv, cache_mla_kpe, cache_gqa_k, cache_gqa_v,
              cache_swa_k, cache_swa_v, c, c_ctx, norm_g, w_ada, b_ada, w_out,
              mla_w_in, mla_q_norm, mla_w_uq, mla_kv_norm, mla_w_ukv,
              gqa_w_in, gqa_q_norm, gqa_k_norm, swa_w_in, swa_sink, final_norm_g):
    T = x_sample.shape[1]
    cos_r, sin_r = axial_rope(T, MLA_ROPE)
    cos_h, sin_h = axial_rope(T, HEAD_DIM)
    xc, xl = x_prompt, x_sample
    st_ckv, st_kpe, st_gk, st_gv, st_sk, st_sv = [], [], [], [], [], []
    for i in range(DEPTH):
        kind, j = i % N_MIXERS, i // N_MIXERS
        sh_c, sc_c, gt_c = adaln(c_ctx, w_ada[i], b_ada[i])
        sh_l, sc_l, gt_l = (m[:, None, :] for m in adaln(c, w_ada[i], b_ada[i]))
        hc = mod_norm(xc, norm_g[i], sh_c, sc_c)
        hl = mod_norm(xl, norm_g[i], sh_l, sc_l)
        if kind == 0:
            qn, qr, ckv, kpe, g_c = mla_project(hc, mla_w_in[j], mla_q_norm[j], mla_w_uq[j], mla_kv_norm[j])
            kn, vv = mla_expand(ckv, mla_w_ukv[j])
            o_c = mla_attend(qn, qr, kn, kpe, vv)
            st_ckv.append(ckv)
            st_kpe.append(kpe)
            qn_l, qr_l, ckv_l, kpe_l, g_l = mla_project(hl, mla_w_in[j], mla_q_norm[j], mla_w_uq[j], mla_kv_norm[j])
            qr_l = rope_2d(qr_l, cos_r, sin_r)
            kpe_l = rope_2d(kpe_l, cos_r, sin_r)
            ckv_all = jnp.concatenate([cache_mla_ckv[:, j], ckv_l], axis=1)
            kpe_all = jnp.concatenate([cache_mla_kpe[:, j], kpe_l], axis=1)
            kn_all, v_all = mla_expand(ckv_all, mla_w_ukv[j])
            o_l = mla_attend(qn_l, qr_l, kn_all, kpe_all, v_all)
        elif kind == 1:
            q, k, vv, g_c = gqa_project(hc, gqa_w_in[j])
            q, k = rms_norm(q, gqa_q_norm[j]), rms_norm(k, gqa_k_norm[j])
            o_c = gqa_dense(q, k, vv)
            st_gk.append(k)
            st_gv.append(vv)
            q_l, k_l, v_l, g_l = gqa_project(hl, gqa_w_in[j])
            q_l = rope_2d(rms_norm(q_l, gqa_q_norm[j]), cos_h, sin_h)
            k_l = rope_2d(rms_norm(k_l, gqa_k_norm[j]), cos_h, sin_h)
            k_all = jnp.concatenate([cache_gqa_k[:, j], k_l], axis=1)
            v_all = jnp.concatenate([cache_gqa_v[:, j], v_l], axis=1)
            o_l = gqa_dense(q_l, k_all, v_all)
        else:
            q, k, vv, g_c = gqa_project(hc, swa_w_in[j])
            o_c = gqa_dense(q, k, vv, sink=swa_sink[j])
            st_sk.append(k)
            st_sv.append(vv)
            q_l, k_l, v_l, g_l = gqa_project(hl, swa_w_in[j])
            q_l = rope_2d(q_l, cos_h, sin_h)
            k_l = rope_2d(k_l, cos_h, sin_h)
            o_l = swa_latent(q_l, k_l, v_l, cache_swa_k[:, j], cache_swa_v[:, j], swa_sink[j])
        xc = xc + gt_c * finish(o_c, g_c, w_out[i])
        xl = xl + gt_l * finish(o_l, g_l, w_out[i])
    y_prompt = rms_norm(xc, final_norm_g)
    y_sample = rms_norm(xl, final_norm_g)
    new_mla_ckv = jnp.stack(st_ckv, axis=1)
    new_mla_kpe = jnp.stack(st_kpe, axis=1)
    new_gqa_k = jnp.stack(st_gk, axis=1)
    new_gqa_v = jnp.stack(st_gv, axis=1)
    new_swa_k = jnp.stack(st_sk, axis=1)
    new_swa_v = jnp.stack(st_sv, axis=1)
    return (y_prompt, y_sample, new_mla_ckv, new_mla_kpe, new_gqa_k, new_gqa_v, new_swa_k, new_swa_v)
```

```cpp
#include <hip/hip_runtime.h>
#include <cstdint>
#include <cstdio>

typedef unsigned short bf16;
typedef float f32x4 __attribute__((ext_vector_type(4)));
typedef unsigned u32x4 __attribute__((ext_vector_type(4)));
typedef unsigned u32x2 __attribute__((ext_vector_type(2)));
#define LAS __attribute__((address_space(3)))

constexpr int D = 1024, NCTX = 8192, NLAT = 4096, MTOK = 12288, LALL = 14336;
constexpr float EPS = 1e-6f;
constexpr float LOG2E = 1.4426950408889634f;
constexpr float C2G = 0.125f * LOG2E;
constexpr float C2M = 0.10206207261596577f * LOG2E;

enum { I_XP = 0, I_XS, I_CCKV, I_CKPE, I_CGK, I_CGV, I_CSK, I_CSV, I_C, I_CCTX, I_NORMG, I_WADA, I_BADA, I_WOUT, I_MWIN, I_MQN, I_MWUQ, I_MKVN, I_MWUKV,
       I_GWIN, I_GQN, I_GKN, I_SWIN, I_SINK, I_FNG, N_IN };

constexpr size_t O_Y = 0, O_CKV = 12582912, O_KPE = 16777216, O_GK = 17301504, O_GV = 19398656, O_SK = 21495808, O_SV = 23592960;

constexpr size_t MiB = 1u << 20;
constexpr size_t WS_CTL = 0, CTL_BYTES = 1 * MiB;
constexpr size_t WS_MOD = 1 * MiB;
constexpr size_t WS_COSH = 1 * MiB + 512 * 1024;
constexpr size_t WS_SINH = WS_COSH + 128 * 1024;
constexpr size_t WS_COSR = WS_SINH + 128 * 1024;
constexpr size_t WS_SINR = WS_COSR + 64 * 1024;
constexpr size_t WS_SSKV = 2 * MiB;
constexpr size_t WS_SSQ = 2 * MiB + 512 * 1024;
constexpr size_t WS_WOUT = 3 * MiB;
constexpr size_t WS_WMIN = 11 * MiB;
constexpr size_t WS_WUQ = 18 * MiB;
constexpr size_t WS_WUKVG = 21 * MiB;
constexpr size_t WS_WUKVP = 23 * MiB;
constexpr size_t WS_WGIN = 25 * MiB;
constexpr size_t WS_WSIN = 30 * MiB;
constexpr size_t WS_H = 36 * MiB;
constexpr size_t WS_Q = 60 * MiB;
constexpr size_t WS_QR = 84 * MiB;
constexpr size_t WS_SG = 96 * MiB;
constexpr size_t WS_KALL = 120 * MiB;
constexpr size_t WS_VALL = 148 * MiB;
constexpr size_t WS_CQ = 176 * MiB;
constexpr size_t WS_CKVA = 185 * MiB;
constexpr size_t WS_KPEA = 199 * MiB;
constexpr size_t WS_GK = 201 * MiB;
constexpr size_t WS_GV = 215 * MiB;
constexpr size_t WS_END = 229 * MiB;

struct Params { const float* in[N_IN]; float* out; unsigned char* ws; };
typedef __attribute__((address_space(4))) const char* kaptr_t;
__device__ __forceinline__ kaptr_t KARG() { kaptr_t ka = (kaptr_t)__builtin_amdgcn_kernarg_segment_ptr(); asm volatile("" : "+s"(ka)); return ka; }
__device__ __forceinline__ const float* INP(int i) { return *(const float* const __attribute__((address_space(4)))*)(KARG() + 8 * i); }
__device__ __forceinline__ float* OUTP() { return *(float* const __attribute__((address_space(4)))*)(KARG() + 8 * N_IN); }
__device__ __forceinline__ unsigned char* WSP() { return *(unsigned char* const __attribute__((address_space(4)))*)(KARG() + 8 * (N_IN + 1)); }

__device__ __forceinline__ int vlaunder(int x) { asm volatile("" : "+v"(x)); return x; }
__device__ __forceinline__ int slaunder(int x) { asm volatile("" : "+s"(x)); return x; }
__device__ __forceinline__ int lane_id() { int l; asm volatile("v_mbcnt_lo_u32_b32 %0, -1, 0\n\tv_mbcnt_hi_u32_b32 %0, -1, %0" : "=v"(l)); return l; }
#define TID_FROM(wid_s) (slaunder(wid_s) * 64 + lane_id())
__device__ __forceinline__ unsigned f2bf(float f) { unsigned u = __builtin_bit_cast(unsigned, f); return (u + 0x7fffu + ((u >> 16) & 1u)) >> 16; }
__device__ __forceinline__ unsigned pk2(float lo, float hi) { return f2bf(lo) | (f2bf(hi) << 16); }
__device__ __forceinline__ float bflo(unsigned w) { return __builtin_bit_cast(float, w << 16); }
__device__ __forceinline__ float bfhi(unsigned w) { return __builtin_bit_cast(float, w & 0xffff0000u); }
__device__ __forceinline__ u32x4 pack8(const float* v) { u32x4 r; r.x = pk2(v[0], v[1]); r.y = pk2(v[2], v[3]); r.z = pk2(v[4], v[5]); r.w = pk2(v[6], v[7]); return r; }
template <int K> __device__ __forceinline__ float swz_xor(float v) { return __builtin_bit_cast(float, __builtin_amdgcn_ds_swizzle(__builtin_bit_cast(int, v), 0x1F | (K << 10))); }
__device__ __forceinline__ void x32_pair(float v, float& a, float& b) { a = v; b = v; asm volatile("s_nop 1\n\tv_permlane32_swap_b32 %0, %1\n\ts_nop 1" : "+v"(a), "+v"(b)); }
__device__ __forceinline__ float x32_sum(float v) { float a, b; x32_pair(v, a, b); return a + b; }
__device__ __forceinline__ float x32_max(float v) { float a, b; x32_pair(v, a, b); return fmaxf(a, b); }
__device__ __forceinline__ float wave_sum(float v) { v += swz_xor<1>(v); v += swz_xor<2>(v); v += swz_xor<4>(v); v += swz_xor<8>(v); v += swz_xor<16>(v); return x32_sum(v); }
__device__ __forceinline__ float wave_max(float v) { v = fmaxf(v, swz_xor<1>(v)); v = fmaxf(v, swz_xor<2>(v)); v = fmaxf(v, swz_xor<4>(v)); v = fmaxf(v, swz_xor<8>(v)); v = fmaxf(v, swz_xor<16>(v)); return x32_max(v); }
__device__ __forceinline__ float silu(float x) { return x / (1.f + __expf(-x)); }
__device__ __forceinline__ void rope8(float* v, const float* cs, const float* sn) {
    const f32x4 c = *(const f32x4*)cs, s = *(const f32x4*)sn;
#pragma unroll
    for (int i = 0; i < 4; ++i) { const float a = v[2 * i], b = v[2 * i + 1]; v[2 * i] = a * c[i] - b * s[i]; v[2 * i + 1] = a * s[i] + b * c[i]; }
}

__device__ __forceinline__ int wt_orig_base(int map, int nb) {
    switch (map) {
    case 0: return 32 * nb;
    case 1: { const int tile = nb >> 3, q = nb & 7, bj = q >> 2, wc = q & 3; return 256 * tile + 64 * wc + 32 * bj; }
    case 2: return nb < 8 ? 384 + 32 * nb : nb < 20 ? 32 * (nb - 8) : nb == 20 ? 640 : nb < 24 ? -1 : 672 + 32 * (nb - 24);
    case 3: if (nb < 32) return 96 * (nb >> 1) + 32 * (nb & 1); else return 96 * (nb - 32) + 64;
    default: if (nb < 32) return 128 * (nb >> 1) + 32 * (nb & 1); else { const int r = nb - 32; return 128 * (r >> 1) + 64 + 32 * (r & 1); }
    }
}
__device__ __forceinline__ void wt_item(const float* W, int K, int Norig, bf16* WT, const float* g, int map, int kb, int nb, LAS float* scr, int lane) {
    const int k0 = 64 * kb, ob = wt_orig_base(map, nb);
    if (ob >= 0) {
#pragma unroll 8
        for (int i = 0; i < 32; ++i) { const int kk = 2 * i + (lane >> 5); scr[kk * 33 + (lane & 31)] = W[(size_t)(k0 + kk) * Norig + ob + (lane & 31)]; }
    } else {
#pragma unroll 8
        for (int i = 0; i < 32; ++i) { const int kk = 2 * i + (lane >> 5); scr[kk * 33 + (lane & 31)] = 0.f; }
    }
    asm volatile("s_waitcnt lgkmcnt(0)" ::: "memory");
    const int c = lane & 7;
    float gs[8];
#pragma unroll
    for (int e = 0; e < 8; ++e) gs[e] = g ? g[k0 + 8 * c + e] : 1.f;
#pragma unroll
    for (int j = 0; j < 4; ++j) { const int n = (lane >> 3) + 8 * j; const LAS float* s = scr + (8 * c) * 33 + n;
        u32x4 o; o.x = pk2(s[0 * 33] * gs[0], s[1 * 33] * gs[1]); o.y = pk2(s[2 * 33] * gs[2], s[3 * 33] * gs[3]); o.z = pk2(s[4 * 33] * gs[4], s[5 * 33] * gs[5]); o.w = pk2(s[6 * 33] * gs[6], s[7 * 33] * gs[7]);
        *(u32x4*)(WT + (size_t)(32 * nb + n) * K + k0 + 8 * c) = o; }
    asm volatile("s_waitcnt lgkmcnt(0)" ::: "memory");
}
constexpr int WT_ITEMS = 2048 + 1792 + 576 + 512 + 512 + 2560;
__device__ __forceinline__ void wt_dispatch(int it, LAS float* scr, int lane) {
    unsigned char* ws = WSP(); int r = it;
    if (r < 2048) { const int i = r >> 9; r &= 511; wt_item(INP(I_WOUT) + (size_t)i * 1024 * 1024, 1024, 1024, (bf16*)(ws + WS_WOUT) + (size_t)i * 1024 * 1024, nullptr, 0, r / 32, r % 32, scr, lane); return; } r -= 2048;
    if (r < 1792) { const int j = r / 896; r %= 896; wt_item(INP(I_MWIN) + (size_t)j * 1024 * 1696, 1024, 1696, (bf16*)(ws + WS_WMIN) + (size_t)j * 1792 * 1024, nullptr, 2, r / 56, r % 56, scr, lane); return; } r -= 1792;
    if (r < 576) { const int j = r / 288; r %= 288; wt_item(INP(I_MWUQ) + (size_t)j * 384 * 1536, 384, 1536, (bf16*)(ws + WS_WUQ) + (size_t)j * 1536 * 384, INP(I_MQN) + j * 384, 3, r / 48, r % 48, scr, lane); return; } r -= 576;
    if (r < 512) { const int j = r / 256; r %= 256; wt_item(INP(I_MWUKV) + (size_t)j * 256 * 2048, 256, 2048, (bf16*)(ws + WS_WUKVG) + (size_t)j * 2048 * 256, INP(I_MKVN) + j * 256, 4, r / 64, r % 64, scr, lane); return; } r -= 512;
    if (r < 512) { const int j = r / 256; r %= 256; wt_item(INP(I_MWUKV) + (size_t)j * 256 * 2048, 256, 2048, (bf16*)(ws + WS_WUKVP) + (size_t)j * 2048 * 256, nullptr, 4, r / 64, r % 64, scr, lane); return; } r -= 512;
    if (r < 1280) { wt_item(INP(I_GWIN), 1024, 2560, (bf16*)(ws + WS_WGIN), nullptr, 1, r / 80, r % 80, scr, lane); return; } r -= 1280;
    wt_item(INP(I_SWIN), 1024, 2560, (bf16*)(ws + WS_WSIN), nullptr, 1, r / 80, r % 80, scr, lane);
}
__device__ __forceinline__ void adaln_item(int it, LAS unsigned char* lds, int tid) {
    LAS float* sv = (LAS float*)lds;
    LAS float* red = (LAS float*)(lds + 20480);
    const int i = it / 48, cg = it % 48;
    for (int idx = tid; idx < 5120; idx += 512) { const int v = idx >> 10, k = idx & 1023; const float x = v == 0 ? INP(I_CCTX)[k] : INP(I_C)[(v - 1) * 1024 + k]; sv[idx] = x / (1.f + expf(-x)); }
    __syncthreads();
    const int kr = tid >> 4, c4 = tid & 15;
    const float* wp = INP(I_WADA) + (size_t)i * 1024 * 3072 + cg * 64 + c4 * 4;
    f32x4 acc[5];
#pragma unroll
    for (int v = 0; v < 5; ++v) acc[v] = (f32x4){0.f, 0.f, 0.f, 0.f};
#pragma unroll 8
    for (int kk = 0; kk < 32; ++kk) { const int k = kk * 32 + kr; const f32x4 w = *(const f32x4*)(wp + (size_t)k * 3072);
#pragma unroll
        for (int v = 0; v < 5; ++v) acc[v] += w * sv[v * 1024 + k]; }
#pragma unroll
    for (int v = 0; v < 5; ++v) *(LAS f32x4*)(red + ((kr * 5 + v) * 64 + c4 * 4)) = acc[v];
    __syncthreads();
    if (tid < 320) { const int v = tid >> 6, col = tid & 63; float s = INP(I_BADA)[i * 3072 + cg * 64 + col];
#pragma unroll 8
        for (int r = 0; r < 32; ++r) s += red[(r * 5 + v) * 64 + col];
        ((float*)(WSP() + WS_MOD))[(size_t)(i * 5 + v) * 3072 + cg * 64 + col] = s; }
    __syncthreads();
}
__device__ __forceinline__ void p0_phase(int wid_s, int vb, int nvb, LAS unsigned char* lds) {
    vb = slaunder(vb); nvb = slaunder(nvb);
    const int tid = TID_FROM(wid_s), lane = tid & 63, wave = tid >> 6;
    for (int it = vb; it < 192; it += nvb) adaln_item(it, lds, tid);
    LAS float* scr = (LAS float*)(lds + wave * 16384);
    const int gw = vb * 8 + wave, NGW = nvb * 8;
    for (int it = gw; it < WT_ITEMS; it += NGW) wt_dispatch(it, scr, lane);
    const int gt = vb * 512 + tid, NGT = nvb * 512;
    unsigned char* ws = WSP();
    for (int it = gt; it < 409600; it += NGT) {
        int r = it; const float* src; bf16* dst;
        if (r < 131072) { const int row = r >> 5, ch = r & 31, b = row >> 10, j = (row >> 9) & 1, s = row & 511;
            src = INP(I_CCKV) + (size_t)row * 256 + ch * 8; dst = (bf16*)(ws + WS_CKVA) + ((size_t)j * LALL + 8192 + b * 1536 + s) * 256 + ch * 8; }
        else if ((r -= 131072) < 16384) { const int row = r >> 2, ch = r & 3, b = row >> 10, j = (row >> 9) & 1, s = row & 511;
            src = INP(I_CKPE) + (size_t)row * 32 + ch * 8; dst = (bf16*)(ws + WS_KPEA) + ((size_t)j * LALL + 8192 + b * 1536 + s) * 32 + ch * 8; }
        else { r -= 16384; const int which = r >> 16; r &= 65535; const int row = r >> 5, ch = r & 31, b = row >> 9, s = row & 511;
            src = (which == 0 ? INP(I_CGK) : which == 1 ? INP(I_CGV) : which == 2 ? INP(I_CSK) : INP(I_CSV)) + (size_t)row * 256 + ch * 8;
            dst = (bf16*)(ws + ((which & 1) ? WS_GV : WS_GK)) + ((size_t)(which >> 1) * LALL + 8192 + b * 1536 + s) * 256 + ch * 8; }
        const f32x4 a = *(const f32x4*)src, bq = *(const f32x4*)(src + 4);
        u32x4 o; o.x = pk2(a[0], a[1]); o.y = pk2(a[2], a[3]); o.z = pk2(bq[0], bq[1]); o.w = pk2(bq[2], bq[3]);
        *(u32x4*)dst = o;
    }
    for (int it = gt; it < 1024 * 48; it += NGT) {
        const int t = it / 48, e = it % 48; const float rowf = (float)(t >> 6), colf = (float)(t & 63);
        float ang; float* cd; float* sd;
        if (e < 32) { const float fr = powf(10000.f, -(float)(e & 15) / 16.f); ang = (e < 16 ? rowf : colf) * fr; cd = (float*)(ws + WS_COSH) + t * 32 + e; sd = (float*)(ws + WS_SINH) + t * 32 + e; }
        else { const int i = e - 32; const float fr = powf(10000.f, -(float)(i & 7) / 8.f); ang = (i < 8 ? rowf : colf) * fr; cd = (float*)(ws + WS_COSR) + t * 16 + i; sd = (float*)(ws + WS_SINR) + t * 16 + i; }
        const float n = rintf(ang * 0.15915494309189535f);
        float rr = fmaf(-n, 6.2831854820251465f, ang); rr = fmaf(-n, -1.7484555e-7f, rr);
        *cd = cosf(rr); *sd = sinf(rr);
    }
}

__device__ __forceinline__ const float* xrow_ptr(int layer, int row) {
    return layer == 0 ? (row < NCTX ? INP(I_XP) + (size_t)row * D : INP(I_XS) + (size_t)(row - NCTX) * D) : OUTP() + (size_t)row * D;
}
__device__ __forceinline__ void norm_phase(int wid_s, int layer, int vb, int nvb) {
    vb = slaunder(vb); nvb = slaunder(nvb); const int tid_ = TID_FROM(wid_s); const int lane = tid_ & 63, gw = vb * 8 + (tid_ >> 6), NGW = nvb * 8;
    const float* g = INP(I_NORMG) + layer * D; bf16* H = (bf16*)(WSP() + WS_H);
    for (int row = gw; row < MTOK; row += NGW) {
        const f32x4* xr = (const f32x4*)xrow_ptr(layer, row) + lane;
        const int v = row < NCTX ? 0 : 1 + ((row - NCTX) >> 10);
        const float* mod = (const float*)(WSP() + WS_MOD) + (size_t)(layer * 5 + v) * 3072;
        f32x4 x[4]; float ss = 0.f;
#pragma unroll
        for (int j = 0; j < 4; ++j) { x[j] = xr[64 * j]; ss += (x[j][0] * x[j][0] + x[j][1] * x[j][1]) + (x[j][2] * x[j][2] + x[j][3] * x[j][3]); }
        const float rstd = rsqrtf(wave_sum(ss) * (1.f / D) + EPS);
#pragma unroll
        for (int j = 0; j < 4; ++j) { const int col = 4 * lane + 256 * j;
            const f32x4 gg = *(const f32x4*)(g + col), sh = *(const f32x4*)(mod + col), sc = *(const f32x4*)(mod + 1024 + col);
            const f32x4 h = x[j] * rstd * gg * (sc + 1.f) + sh;
            u32x2 o; o.x = pk2(h[0], h[1]); o.y = pk2(h[2], h[3]);
            *(u32x2*)(H + (size_t)row * D + col) = o; }
    }
}
__device__ __forceinline__ void final_phase(int wid_s, int vb, int nvb) {
    vb = slaunder(vb); nvb = slaunder(nvb); const int tid_ = TID_FROM(wid_s); const int lane = tid_ & 63, gw = vb * 8 + (tid_ >> 6), NGW = nvb * 8;
    const float* g = INP(I_FNG);
    for (int row = gw; row < MTOK; row += NGW) {
        f32x4* xr = (f32x4*)(OUTP() + (size_t)row * D) + lane;
        f32x4 x[4]; float ss = 0.f;
#pragma unroll
        for (int j = 0; j < 4; ++j) { x[j] = xr[64 * j]; ss += (x[j][0] * x[j][0] + x[j][1] * x[j][1]) + (x[j][2] * x[j][2] + x[j][3] * x[j][3]); }
        const float rstd = rsqrtf(wave_sum(ss) * (1.f / D) + EPS);
#pragma unroll
        for (int j = 0; j < 4; ++j) xr[64 * j] = x[j] * rstd * *(const f32x4*)(g + 4 * lane + 256 * j);
    }
}
__device__ __forceinline__ void ckvfix_phase(int wid_s, int j, int vb, int nvb) {
    vb = slaunder(vb); nvb = slaunder(nvb); const int tid_ = TID_FROM(wid_s); const int lane = tid_ & 63, gw = vb * 8 + (tid_ >> 6), NGW = nvb * 8;
    const float* g = INP(I_MKVN) + j * 256; const float* SS = (const float*)(WSP() + WS_SSKV);
    for (int row = gw; row < NCTX; row += NGW) {
        const f32x4 ss = *(const f32x4*)(SS + row * 4);
        const float rstd = rsqrtf(((ss[0] + ss[1]) + (ss[2] + ss[3])) * (1.f / 256.f) + EPS);
        f32x4* p = (f32x4*)(OUTP() + O_CKV + ((size_t)((row >> 8) * 2 + j) * 256 + (row & 255)) * 256) + lane;
        *p = *p * rstd * *(const f32x4*)(g + 4 * lane);
    }
}

struct Unit { int pm, pn; };
typedef f32x4 Acc[2][2][4][2];
#define LOADV8(v, ai, bj, m) do { const f32x4 _a = acc[ai][bj][m][0], _b = acc[ai][bj][m][1]; v[0] = _a[0]; v[1] = _a[1]; v[2] = _a[2]; v[3] = _a[3]; v[4] = _b[0]; v[5] = _b[1]; v[6] = _b[2]; v[7] = _b[3]; } while (0)

struct EpiMlaIn {
    static constexpr bool PERM = true;
    int j;
    __device__ __forceinline__ void operator()(const Acc& acc, const Unit& u, int wr, int wc, int fr, int fq) const {
        unsigned char* ws = WSP(); float* out = OUTP();
        bf16* ckva = (bf16*)(ws + WS_CKVA) + (size_t)j * LALL * 256; bf16* kpea = (bf16*)(ws + WS_KPEA) + (size_t)j * LALL * 32; bf16* cq = (bf16*)(ws + WS_CQ); bf16* sg = (bf16*)(ws + WS_SG);
        float* outckv = out + O_CKV; float* outkpe = out + O_KPE; float* sskv = (float*)(ws + WS_SSKV); float* ssq = (float*)(ws + WS_SSQ);
        const float* cosR = (const float*)(ws + WS_COSR); const float* sinR = (const float*)(ws + WS_SINR);
#pragma unroll
        for (int ai = 0; ai < 2; ++ai)
#pragma unroll
            for (int m = 0; m < 4; ++m) {
                asm volatile("" ::: "memory");
                const int row = u.pm * 256 + ai * 128 + wr * 64 + m * 16 + fr;
                const bool lat = row >= NCTX; const int t = (row - NCTX) & 1023, b = (row - NCTX) >> 10;
                const int krow = lat ? NCTX + b * 1536 + 512 + t : row;
                const size_t orow = (size_t)((row >> 8) * 2 + j) * 256 + (row & 255);
                float v[2][8]; LOADV8(v[0], ai, 0, m); LOADV8(v[1], ai, 1, m);
                if (u.pn <= 2) {
                    float ss = 0.f;
#pragma unroll
                    for (int bj = 0; bj < 2; ++bj) { if (u.pn == 2 && bj == 1) break;
#pragma unroll
                        for (int i = 0; i < 8; ++i) ss += v[bj][i] * v[bj][i]; }
                    ss += swz_xor<16>(ss); ss = x32_sum(ss);
                    if (u.pn == 0) {
#pragma unroll
                        for (int bj = 0; bj < 2; ++bj) { const int lc = 128 * bj + 32 * wc + 8 * fq;
                            *(u32x4*)(ckva + (size_t)krow * 256 + lc) = pack8(v[bj]);
                            if (!lat) { float* o = outckv + orow * 256 + lc; *(f32x4*)o = acc[ai][bj][m][0]; *(f32x4*)(o + 4) = acc[ai][bj][m][1]; } }
                        if (fq == 0) sskv[row * 4 + wc] = ss;
                    } else if (u.pn == 1) {
#pragma unroll
                        for (int bj = 0; bj < 2; ++bj) *(u32x4*)(cq + (size_t)row * 384 + 128 * bj + 32 * wc + 8 * fq) = pack8(v[bj]);
                        if (fq == 0) ssq[row * 8 + wc] = ss;
                    } else {
                        *(u32x4*)(cq + (size_t)row * 384 + 256 + 32 * wc + 8 * fq) = pack8(v[0]);
                        if (fq == 0) ssq[row * 8 + 4 + wc] = ss;
                        if (wc == 0) {
                            if (!lat) { float* o = outkpe + orow * 32 + 8 * fq; *(f32x4*)o = acc[ai][1][m][0]; *(f32x4*)(o + 4) = acc[ai][1][m][1]; }
                            else rope8(v[1], cosR + t * 16 + 4 * fq, sinR + t * 16 + 4 * fq);
                            *(u32x4*)(kpea + (size_t)krow * 32 + 8 * fq) = pack8(v[1]);
                        }
                    }
                } else {
#pragma unroll
                    for (int bj = 0; bj < 2; ++bj) {
#pragma unroll
                        for (int i = 0; i < 8; ++i) v[bj][i] = silu(v[bj][i]);
                        *(u32x4*)(sg + (size_t)row * D + (u.pn - 3) * 256 + 128 * bj + 32 * wc + 8 * fq) = pack8(v[bj]); }
                }
            }
    }
};
struct EpiMlaUq {
    static constexpr bool PERM = true;
    int dummy;
    __device__ __forceinline__ void operator()(const Acc& acc, const Unit& u, int wr, int wc, int fr, int fq) const {
        unsigned char* ws = WSP();
        bf16* qn = (bf16*)(ws + WS_Q); bf16* qr = (bf16*)(ws + WS_QR); const float* ssq = (const float*)(ws + WS_SSQ);
        const float* cosR = (const float*)(ws + WS_COSR); const float* sinR = (const float*)(ws + WS_SINR);
#pragma unroll
        for (int ai = 0; ai < 2; ++ai)
#pragma unroll
            for (int m = 0; m < 4; ++m) {
                asm volatile("" ::: "memory");
                const int row = u.pm * 256 + ai * 128 + wr * 64 + m * 16 + fr;
                const bool lat = row >= NCTX; const int t = (row - NCTX) & 1023;
                const f32x4 s0 = *(const f32x4*)(ssq + row * 8), s1 = *(const f32x4*)(ssq + row * 8 + 4);
                const float rstd = rsqrtf((((s0[0] + s0[1]) + (s0[2] + s0[3])) + ((s1[0] + s1[1]) + (s1[2] + s1[3]))) * (1.f / 384.f) + EPS) * C2M;
#pragma unroll
                for (int bj = 0; bj < 2; ++bj) { float v[8]; LOADV8(v, ai, bj, m);
#pragma unroll
                    for (int i = 0; i < 8; ++i) v[i] *= rstd;
                    const int lc = 128 * bj + 32 * wc + 8 * fq;
                    if (u.pn < 4) *(u32x4*)(qn + (size_t)row * D + 256 * u.pn + lc) = pack8(v);
                    else { const int pr = 256 * (u.pn - 4) + lc; if (lat) rope8(v, cosR + t * 16 + ((pr & 31) >> 1), sinR + t * 16 + ((pr & 31) >> 1));
                        *(u32x4*)(qr + (size_t)row * 512 + pr) = pack8(v); } }
            }
    }
};
__device__ __forceinline__ bool ukv_cache_tile(int pm) { return pm >= 32 && ((pm - 32) % 6) < 2; }
struct EpiMlaUkv {
    static constexpr bool PERM = true;
    int dummy;
    __device__ __forceinline__ void operator()(const Acc& acc, const Unit& u, int wr, int wc, int fr, int fq) const {
        unsigned char* ws = WSP();
        bf16* kall = (bf16*)(ws + WS_KALL); bf16* vall = (bf16*)(ws + WS_VALL); const float* sskv = (const float*)(ws + WS_SSKV);
        const bool cache = ukv_cache_tile(u.pm);
#pragma unroll
        for (int ai = 0; ai < 2; ++ai)
#pragma unroll
            for (int m = 0; m < 4; ++m) {
                asm volatile("" ::: "memory");
                const int krow = u.pm * 256 + ai * 128 + wr * 64 + m * 16 + fr;
                float rstd = 1.f;
                if (!cache) { int trow = krow; if (krow >= NCTX) { const int b = (krow - NCTX) / 1536, p = (krow - NCTX) % 1536; trow = NCTX + b * 1024 + (p - 512); }
                    const f32x4 ss = *(const f32x4*)(sskv + trow * 4); rstd = rsqrtf(((ss[0] + ss[1]) + (ss[2] + ss[3])) * (1.f / 256.f) + EPS); }
#pragma unroll
                for (int bj = 0; bj < 2; ++bj) { float v[8]; LOADV8(v, ai, bj, m);
#pragma unroll
                    for (int i = 0; i < 8; ++i) v[i] *= rstd;
                    const int lc = 128 * bj + 32 * wc + 8 * fq;
                    if (u.pn < 4) *(u32x4*)(kall + (size_t)krow * D + 256 * u.pn + lc) = pack8(v);
                    else *(u32x4*)(vall + (size_t)krow * D + 256 * (u.pn - 4) + lc) = pack8(v); }
            }
    }
};
struct EpiGqaIn {
    static constexpr bool PERM = true;
    int kind;
    __device__ __forceinline__ void operator()(const Acc& acc, const Unit& u, int wr, int wc, int fr, int fq) const {
        unsigned char* ws = WSP(); float* out = OUTP();
        bf16* q = (bf16*)(ws + WS_Q); bf16* sg = (bf16*)(ws + WS_SG);
        bf16* gk = (bf16*)(ws + WS_GK) + (size_t)(kind - 1) * LALL * 256; bf16* gv = (bf16*)(ws + WS_GV) + (size_t)(kind - 1) * LALL * 256;
        float* outk = out + (kind == 1 ? O_GK : O_SK); float* outv = out + (kind == 1 ? O_GV : O_SV);
        const float* cosH = (const float*)(ws + WS_COSH); const float* sinH = (const float*)(ws + WS_SINH);
#pragma unroll
        for (int ai = 0; ai < 2; ++ai)
#pragma unroll
            for (int m = 0; m < 4; ++m) {
                asm volatile("" ::: "memory");
                const int row = u.pm * 256 + ai * 128 + wr * 64 + m * 16 + fr;
                const bool lat = row >= NCTX; const int t = (row - NCTX) & 1023, b = (row - NCTX) >> 10;
                const int krow = lat ? NCTX + b * 1536 + 512 + t : row;
                float v[2][8]; LOADV8(v[0], ai, 0, m); LOADV8(v[1], ai, 1, m);
                if (u.pn <= 4) {
                    if (kind == 1) {
                        float ss = 0.f;
#pragma unroll
                        for (int bj = 0; bj < 2; ++bj)
#pragma unroll
                            for (int i = 0; i < 8; ++i) ss += v[bj][i] * v[bj][i];
                        ss += swz_xor<16>(ss); ss = x32_sum(ss);
                        const float rstd = rsqrtf(ss * (1.f / 64.f) + EPS); const float* g = u.pn < 4 ? INP(I_GQN) : INP(I_GKN);
#pragma unroll
                        for (int bj = 0; bj < 2; ++bj) { const f32x4 g0 = *(const f32x4*)(g + 32 * bj + 8 * fq), g1 = *(const f32x4*)(g + 32 * bj + 8 * fq + 4);
#pragma unroll
                            #ifdef PROBE_NOG
                            for (int i = 0; i < 4; ++i) { v[bj][i] *= rstd * (u.pn == 4 ? 1.f : g0[i]); v[bj][4 + i] *= rstd * (u.pn == 4 ? 1.f : g1[i]); } }
#else
                            for (int i = 0; i < 4; ++i) { v[bj][i] *= rstd * g0[i]; v[bj][4 + i] *= rstd * g1[i]; } }
#endif
                    }
#pragma unroll
                    for (int bj = 0; bj < 2; ++bj) { const int d0 = 32 * bj + 8 * fq;
                        if (u.pn == 4 && !lat) { float* o = outk + (size_t)row * 256 + wc * 64 + d0; *(f32x4*)o = (f32x4){v[bj][0], v[bj][1], v[bj][2], v[bj][3]}; *(f32x4*)(o + 4) = (f32x4){v[bj][4], v[bj][5], v[bj][6], v[bj][7]}; }
                        if (lat) rope8(v[bj], cosH + t * 32 + (d0 >> 1), sinH + t * 32 + (d0 >> 1));
                        if (u.pn < 4) {
#pragma unroll
                            for (int i = 0; i < 8; ++i) v[bj][i] *= C2G;
                            *(u32x4*)(q + (size_t)row * D + (4 * u.pn + wc) * 64 + d0) = pack8(v[bj]);
                        } else *(u32x4*)(gk + (size_t)krow * 256 + wc * 64 + d0) = pack8(v[bj]); }
                } else if (u.pn == 5) {
#pragma unroll
                    for (int bj = 0; bj < 2; ++bj) { const int d0 = 32 * bj + 8 * fq;
                        if (!lat) { float* o = outv + (size_t)row * 256 + wc * 64 + d0; *(f32x4*)o = acc[ai][bj][m][0]; *(f32x4*)(o + 4) = acc[ai][bj][m][1]; }
                        *(u32x4*)(gv + (size_t)krow * 256 + wc * 64 + d0) = pack8(v[bj]); }
                } else {
#pragma unroll
                    for (int bj = 0; bj < 2; ++bj) {
#pragma unroll
                        for (int i = 0; i < 8; ++i) v[bj][i] = silu(v[bj][i]);
                        *(u32x4*)(sg + (size_t)row * D + (u.pn - 6) * 256 + 64 * wc + 32 * bj + 8 * fq) = pack8(v[bj]); }
                }
            }
    }
};
struct EpiOut {
    static constexpr bool PERM = false;
    int layer;
    __device__ __forceinline__ void operator()(const Acc& acc, const Unit& u, int wr, int wc, int fr, int fq) const {
        float* out = OUTP(); const float* mod = (const float*)(WSP() + WS_MOD);
        const int vv = u.pm < 32 ? 0 : 1 + ((u.pm - 32) >> 2);
        const float* gate = mod + (size_t)(layer * 5 + vv) * 3072 + 2048;
#pragma unroll
        for (int ai = 0; ai < 2; ++ai)
#pragma unroll
            for (int m = 0; m < 4; ++m) {
                asm volatile("" ::: "memory");
                const int row = u.pm * 256 + ai * 128 + wr * 64 + m * 16 + fr;
                const float* base = layer == 0 ? (row < NCTX ? INP(I_XP) + (size_t)row * D : INP(I_XS) + (size_t)(row - NCTX) * D) : out + (size_t)row * D;
#pragma unroll
                for (int bj = 0; bj < 2; ++bj)
#pragma unroll
                    for (int n = 0; n < 2; ++n) { const int col = 256 * u.pn + 128 * bj + 32 * wc + 16 * n + 4 * fq;
                        #ifdef PROBE_ZERO_MASK
                        *(f32x4*)(out + (size_t)row * D + col) = ((PROBE_ZERO_MASK >> layer) & 1) ? *(const f32x4*)(base + col) : *(const f32x4*)(base + col) + *(const f32x4*)(gate + col) * acc[ai][bj][m][n]; }
#else
                        *(f32x4*)(out + (size_t)row * D + col) = *(const f32x4*)(base + col) + *(const f32x4*)(gate + col) * acc[ai][bj][m][n]; }
#endif
            }
    }
};

namespace pg8 {
typedef short bf16x8 __attribute__((ext_vector_type(8)));
constexpr int BM = 256, BK = 64, HALF = 128, HTB = HALF * BK * 2, STAGE_BYTES = 8 * HTB, NXCD = 8, WGM = 8;
__host__ __device__ __forceinline__ int lds_byte(int r, int c) { const int st = (r >> 4) * 2 + (c >> 5), rr = r & 15, cc = c & 31, ob = rr * 64 + cc * 2; return st * 1024 + (ob ^ (((ob >> 9) & 1) << 5)); }
__host__ __device__ __forceinline__ void stage_rc(int b, int& R, int& C) { const int st = b / 1024, sb = b % 1024, swz = sb ^ (((sb >> 9) & 1) << 5); R = (st >> 1) * 16 + swz / 64; C = (st & 1) * 32 + (swz % 64) / 2; }
__host__ __device__ __forceinline__ int perm32(int rho) { const int n = rho >> 4, i = rho & 15; return 8 * (i >> 2) + 4 * n + (i & 3); }
struct Gemm { const bf16* A; const bf16* Bt; long alt_delta; };
template <bool ALT> __device__ __forceinline__ const char* bbase(const Gemm& g, const Unit& u) { if constexpr (ALT) return (const char*)g.Bt + (ukv_cache_tile(u.pm) ? g.alt_delta : 0l); else return (const char*)g.Bt; }
struct StaticOrder {
    int nM, nN, nwg, G, c;
    __host__ __device__ void init(int M, int N, int G_, int c_) { nM = M / BM; nN = N / BM; nwg = nM * nN; G = G_; c = c_; }
    __host__ __device__ bool next(int i, Unit& u) const {
        const long L = (long)i * G + c; if (L >= nwg) return false;
        int wgid = (int)L; { const int q = nwg / NXCD, r = nwg % NXCD, xcd = wgid % NXCD, off = wgid / NXCD; wgid = (xcd < r ? xcd * (q + 1) : r * (q + 1) + (xcd - r) * q) + off; }
        const int nig = WGM * nN, gid = wgid / nig, fm = gid * WGM, gsz = (nM - fm) < WGM ? (nM - fm) : WGM;
        u.pm = fm + ((wgid % nig) % gsz); u.pn = (wgid % nig) / gsz; return true;
    }
};
template <int K, bool ALT, class Epi, class Sched>
__device__ __forceinline__ void gemm_phase(int wid_s, LAS unsigned char* lds, const Gemm g, const Sched& S, const Epi& E) {
    const int wid = slaunder(wid_s), lane = lane_id(), tid = wid * 64 + lane, wr = wid >> 2, wc = wid & 3, fr = lane & 15, fq = lane >> 4;
    constexpr int nt = K / BK;
    unsigned voffA[2], voffB[2];
#pragma unroll
    for (int i = 0; i < 2; ++i) { int R, C; stage_rc(tid * 16 + i * 8192, R, C); const int Rb = Epi::PERM ? ((R & ~31) + perm32(R & 31)) : R;
        voffA[i] = (unsigned)(R * K + C) * 2u; voffB[i] = (unsigned)(Rb * K + C) * 2u; }
    constexpr size_t kstep = (size_t)(BK * 2);
    constexpr size_t hstep = (size_t)HALF * K * 2;
    constexpr size_t tstep = 2 * hstep;
    const unsigned ldsw = (unsigned)wid * 1024u;
    const int aoff = lds_byte(wr * 64 + fr, fq * 8), boff = lds_byte(wc * 32 + fr, fq * 8);
#define PG8_SA(b, h) (((b) * 2 + (h)) * HTB)
#define PG8_SB(b, h) ((4 + (b) * 2 + (h)) * HTB)
#define PG8_STAGE(bufoff, gbase, voff) do { _Pragma("unroll") for (int _i = 0; _i < 2; ++_i) \
        __builtin_amdgcn_global_load_lds((const unsigned*)((const char*)(gbase) + (voff)[_i]), (LAS unsigned*)(lds + (bufoff) + ldsw + _i * 8192), 16, 0, 0); } while (0)
#define PG8_LDA(dst, b, h) do { _Pragma("unroll") for (int m = 0; m < 4; ++m) _Pragma("unroll") for (int k = 0; k < 2; ++k) dst[m][k] = *(const LAS bf16x8*)(lds + PG8_SA(b, h) + aoff + m * 2048 + k * 1024); } while (0)
#define PG8_LDB(dst, b, h) do { _Pragma("unroll") for (int n = 0; n < 2; ++n) _Pragma("unroll") for (int k = 0; k < 2; ++k) dst[n][k] = *(const LAS bf16x8*)(lds + PG8_SB(b, h) + boff + n * 2048 + k * 1024); } while (0)
#define PG8_MMA(ai, bj, At, Bt) do { __builtin_amdgcn_s_setprio(1); _Pragma("unroll") for (int m = 0; m < 4; ++m) _Pragma("unroll") for (int n = 0; n < 2; ++n) _Pragma("unroll") for (int k = 0; k < 2; ++k) \
        acc[ai][bj][m][n] = __builtin_amdgcn_mfma_f32_16x16x32_bf16(Bt[n][k], At[m][k], acc[ai][bj][m][n], 0, 0, 0); __builtin_amdgcn_s_setprio(0); } while (0)
#define PG8_WAIT_V(n) asm volatile("s_waitcnt vmcnt(" #n ")" ::: "memory")
#define PG8_WAIT_L(n) asm volatile("s_waitcnt lgkmcnt(" #n ")" ::: "memory")
#define PG8_BAR __builtin_amdgcn_s_barrier()
#define PG8_SCHED __builtin_amdgcn_sched_barrier(0)
    Unit cur, nxt; int ui = 0;
    if (!S.next(0, cur)) return;
    f32x4 acc[2][2][4][2];
#pragma unroll
    for (int a = 0; a < 2; ++a)
#pragma unroll
        for (int b = 0; b < 2; ++b)
#pragma unroll
            for (int m = 0; m < 4; ++m)
#pragma unroll
                for (int n = 0; n < 2; ++n) acc[a][b][m][n] = (f32x4){0.f, 0.f, 0.f, 0.f};
    bf16x8 At[4][2], B0[2][2], B1[2][2];
    const char* cA = (const char*)g.A + (size_t)cur.pm * tstep; const char* cB = bbase<ALT>(g, cur) + (size_t)cur.pn * tstep;
    PG8_STAGE(PG8_SB(0, 0), cB, voffB); PG8_STAGE(PG8_SB(0, 1), cB + hstep, voffB); PG8_STAGE(PG8_SA(0, 0), cA, voffA); PG8_STAGE(PG8_SA(0, 1), cA + hstep, voffA);
    if (wr == 1) PG8_BAR;
    PG8_WAIT_V(2); PG8_BAR;
    PG8_STAGE(PG8_SB(1, 0), cB + kstep, voffB); PG8_STAGE(PG8_SA(1, 0), cA + kstep, voffA); PG8_STAGE(PG8_SB(1, 1), cB + hstep + kstep, voffB);
    PG8_WAIT_V(6); PG8_BAR;
    for (;;) {
        const bool has_next = S.next(ui + 1, nxt);
        const char* nA = has_next ? (const char*)g.A + (size_t)nxt.pm * tstep : cA; const char* nB = has_next ? bbase<ALT>(g, nxt) + (size_t)nxt.pn * tstep : cB;
#pragma unroll 1
        for (int t = 0; t < nt; t += 2) {
            const bool last = (t == nt - 2);
            const char* a1 = cA + (size_t)(t + 1) * kstep;
            const char* a2 = last ? nA : cA + (size_t)(t + 2) * kstep; const char* b2 = last ? nB : cB + (size_t)(t + 2) * kstep;
            const char* a3 = a2 + kstep; const char* b3 = b2 + kstep;
            PG8_LDB(B0, 0, 0); PG8_LDB(B1, 0, 1); PG8_SCHED; PG8_LDA(At, 0, 0); PG8_STAGE(PG8_SA(1, 1), a1 + hstep, voffA);
            PG8_WAIT_V(8); PG8_WAIT_L(0); PG8_BAR; PG8_MMA(0, 0, At, B0); PG8_MMA(0, 1, At, B1); PG8_BAR; PG8_SCHED;
            PG8_LDA(At, 0, 1); PG8_STAGE(PG8_SB(0, 0), b2, voffB); PG8_STAGE(PG8_SB(0, 1), b2 + hstep, voffB); PG8_STAGE(PG8_SA(0, 0), a2, voffA);
            PG8_WAIT_V(8); PG8_WAIT_L(0); PG8_BAR; PG8_MMA(1, 0, At, B0); PG8_MMA(1, 1, At, B1); PG8_BAR; PG8_SCHED;
            PG8_LDB(B0, 1, 0); PG8_LDB(B1, 1, 1); PG8_SCHED; PG8_LDA(At, 1, 0); PG8_STAGE(PG8_SA(0, 1), a2 + hstep, voffA);
            PG8_WAIT_V(8); PG8_WAIT_L(0); PG8_BAR; PG8_MMA(0, 0, At, B0); PG8_MMA(0, 1, At, B1); PG8_BAR; PG8_SCHED;
            PG8_LDA(At, 1, 1); PG8_STAGE(PG8_SB(1, 0), b3, voffB); PG8_STAGE(PG8_SB(1, 1), b3 + hstep, voffB); PG8_STAGE(PG8_SA(1, 0), a3, voffA);
            PG8_WAIT_V(8); PG8_WAIT_L(0); PG8_BAR; PG8_MMA(1, 0, At, B0); PG8_MMA(1, 1, At, B1); PG8_BAR; PG8_SCHED;
        }
        if (wr == 0) PG8_BAR;
        { const int l2 = lane_id(); E(acc, cur, wid >> 2, wid & 3, l2 & 15, l2 >> 4); }
        if (!has_next) break;
#pragma unroll
        for (int a = 0; a < 2; ++a)
#pragma unroll
            for (int b = 0; b < 2; ++b)
#pragma unroll
                for (int m = 0; m < 4; ++m)
#pragma unroll
                    for (int n = 0; n < 2; ++n) acc[a][b][m][n] = (f32x4){0.f, 0.f, 0.f, 0.f};
        cur = nxt; cA = nA; cB = nB; ++ui;
        if (wr == 1) PG8_BAR;
    }
    PG8_WAIT_V(0);
    PG8_BAR;
#undef PG8_SA
#undef PG8_SB
#undef PG8_STAGE
#undef PG8_LDA
#undef PG8_LDB
#undef PG8_MMA
#undef PG8_WAIT_V
#undef PG8_WAIT_L
#undef PG8_BAR
#undef PG8_SCHED
}
}

struct AttnArgs { int kind; const bf16 *Q, *Qr, *K, *Kr, *V; int kpitch; const bf16* SG; bf16* O; const float* sink; };
__device__ __forceinline__ void attn_naive_phase(int wid_s, const AttnArgs& a, int vb, int nvb) {
    vb = slaunder(vb); nvb = slaunder(nvb); const int tid_ = TID_FROM(wid_s);
    const int lane = tid_ & 63, gw = vb * 8 + (tid_ >> 6), NGW = nvb * 8;
    for (int it = gw; it < MTOK * 16; it += NGW) {
        const int row = it >> 4, hq = it & 15;
        const bool lat = row >= NCTX; const int b = lat ? (row - NCTX) >> 10 : row >> 8, t = (row - NCTX) & 1023;
        const int kbase = lat ? NCTX + b * 1536 : b * 256, NK = lat ? 1536 : 256;
        const int kh = a.kind == 0 ? hq : hq >> 2;
        float q[96];
#pragma unroll
        for (int c = 0; c < 8; ++c) { const u32x4 w = *(const u32x4*)(a.Q + (size_t)row * D + hq * 64 + c * 8);
            q[8 * c] = bflo(w.x); q[8 * c + 1] = bfhi(w.x); q[8 * c + 2] = bflo(w.y); q[8 * c + 3] = bfhi(w.y); q[8 * c + 4] = bflo(w.z); q[8 * c + 5] = bfhi(w.z); q[8 * c + 6] = bflo(w.w); q[8 * c + 7] = bfhi(w.w); }
        if (a.kind == 0) {
#pragma unroll
            for (int c = 0; c < 4; ++c) { const u32x4 w = *(const u32x4*)(a.Qr + (size_t)row * 512 + hq * 32 + c * 8);
                q[64 + 8 * c] = bflo(w.x); q[64 + 8 * c + 1] = bfhi(w.x); q[64 + 8 * c + 2] = bflo(w.y); q[64 + 8 * c + 3] = bfhi(w.y); q[64 + 8 * c + 4] = bflo(w.z); q[64 + 8 * c + 5] = bfhi(w.z); q[64 + 8 * c + 6] = bflo(w.w); q[64 + 8 * c + 7] = bfhi(w.w); }
        }
        float s[24]; float mx = -INFINITY;
#pragma unroll
        for (int i = 0; i < 24; ++i) {
            s[i] = -INFINITY;
            const int kk = lane + 64 * i;
            bool valid = kk < NK;
            if (a.kind == 2 && lat && kk >= 512) { const int dd = kk - 512 - t; valid = valid && dd <= 128 && dd >= -128; }
            if (64 * i < NK && valid) {
                const bf16* kp = a.K + (size_t)(kbase + kk) * a.kpitch + kh * 64; float acc = 0.f;
#pragma unroll
                for (int c = 0; c < 8; ++c) { const u32x4 w = *(const u32x4*)(kp + c * 8);
                    acc += q[8 * c] * bflo(w.x) + q[8 * c + 1] * bfhi(w.x) + q[8 * c + 2] * bflo(w.y) + q[8 * c + 3] * bfhi(w.y) + q[8 * c + 4] * bflo(w.z) + q[8 * c + 5] * bfhi(w.z) + q[8 * c + 6] * bflo(w.w) + q[8 * c + 7] * bfhi(w.w); }
                if (a.kind == 0) { const bf16* kr = a.Kr + (size_t)(kbase + kk) * 32;
#pragma unroll
                    for (int c = 0; c < 4; ++c) { const u32x4 w = *(const u32x4*)(kr + c * 8);
                        acc += q[64 + 8 * c] * bflo(w.x) + q[64 + 8 * c + 1] * bfhi(w.x) + q[64 + 8 * c + 2] * bflo(w.y) + q[64 + 8 * c + 3] * bfhi(w.y) + q[64 + 8 * c + 4] * bflo(w.z) + q[64 + 8 * c + 5] * bfhi(w.z) + q[64 + 8 * c + 6] * bflo(w.w) + q[64 + 8 * c + 7] * bfhi(w.w); } }
#ifdef PROBE_UNIF
                acc = 0.f;
#endif
                s[i] = acc; mx = fmaxf(mx, acc);
            }
        }
        mx = wave_max(mx);
        float l = 0.f;
#pragma unroll
        for (int i = 0; i < 24; ++i) { s[i] = exp2f(s[i] - mx); l += s[i]; }
        l = wave_sum(l);
        if (a.kind == 2) l += exp2f(a.sink[hq] * LOG2E - mx);
        float o = 0.f;
#pragma unroll
        for (int i = 0; i < 24; ++i) {
            if (64 * i < NK) {
                const bf16* vp = a.V + (size_t)(kbase + 64 * i) * a.kpitch + kh * 64 + lane;
                for (int src = 0; src < 64; ++src) { const float p = __builtin_bit_cast(float, __builtin_amdgcn_readlane(__builtin_bit_cast(int, s[i]), src)); o += p * __builtin_bit_cast(float, (unsigned)vp[(size_t)src * a.kpitch] << 16); }
            }
        }
        const float sgv = __builtin_bit_cast(float, (unsigned)a.SG[(size_t)row * D + hq * 64 + lane] << 16);
        a.O[(size_t)row * D + hq * 64 + lane] = (bf16)f2bf(o / l * sgv);
    }
}

typedef __attribute__((address_space(1))) unsigned gu32;
#define XB_TMO      128
#define XB_XCNT(j)  (256  + 64 * (j))
#define XB_XSUB(j)  (1280 + 64 * (j))
#define XB_XGEN(j)  (2304 + 64 * (j))
#define XB_TOP      3328
#define XB_TOPGEN   3392
#define XCD_BAR_WORDS 3456
#define XB_SPIN_CAP (1u << 18)
__device__ __forceinline__ unsigned xb_ld(unsigned* p)              { return __hip_atomic_load(p, __ATOMIC_RELAXED, __HIP_MEMORY_SCOPE_AGENT); }
__device__ __forceinline__ unsigned xb_add(unsigned* p, unsigned v) { return __hip_atomic_fetch_add(p, v, __ATOMIC_RELAXED, __HIP_MEMORY_SCOPE_AGENT); }
__device__ __forceinline__ unsigned xb_xcc_id() { return (unsigned)__builtin_amdgcn_s_getreg((3 << 11) | 20) & 0xFu; }
#define XB_SPIN(cond, bar) do { unsigned _sp = 0; while (cond) { __builtin_amdgcn_s_sleep(1); \
    if ((++_sp & 255u) == 0u) { if (xb_ld(&(bar)[XB_TMO])) break; if (_sp > XB_SPIN_CAP) { atomicAdd(&(bar)[XB_TMO], 1u); break; } } } } while (0)
struct XcdBarrier { unsigned* bar; unsigned x; volatile LAS unsigned* st; };
__device__ __forceinline__ XcdBarrier xcd_barrier_post(unsigned* bar, volatile LAS unsigned* st) {
    XcdBarrier b; b.bar = bar; b.x = xb_xcc_id(); b.st = st;
    if (threadIdx.x == 0) (void)xb_add(&bar[XB_XCNT(b.x)], 1u);
    return b;
}
__device__ __forceinline__ void xcd_barrier_complete(unsigned* bar, unsigned x, unsigned& nloc, unsigned& nx) {
    const unsigned G = gridDim.x * gridDim.y * gridDim.z;
    unsigned sum, cnt, mine, sp = 0u;
    for (;;) {
        sum = 0u; cnt = 0u; mine = 0u;
#pragma unroll
        for (unsigned j = 0; j < 16; ++j) { const unsigned c = xb_ld(&bar[XB_XCNT(j)]); sum += c; cnt += (c > 0u) ? 1u : 0u; mine = (j == x) ? c : mine; }
        if (sum == G) break;
        __builtin_amdgcn_s_sleep(1);
        if ((++sp & 255u) == 0u) { if (xb_ld(&bar[XB_TMO])) break; if (sp > XB_SPIN_CAP) { atomicAdd(&bar[XB_TMO], 1u); break; } }
    }
    nloc = mine > 0u ? mine : 1u; nx = cnt > 0u ? cnt : 1u;
}
__device__ __forceinline__ void xcd_barrier(const XcdBarrier& b) {
    asm volatile("s_waitcnt vmcnt(0)" ::: "memory");
    __syncthreads();
    if (threadIdx.x == 0) {
        unsigned* bar = b.bar;
        __builtin_amdgcn_s_waitcnt(0);
        unsigned nloc = b.st[0], nx = b.st[1];
        if (nloc == 0u) { xcd_barrier_complete(bar, b.x, nloc, nx); b.st[0] = nloc; b.st[1] = nx; }
        const unsigned old = xb_add(&bar[XB_XSUB(b.x)], 1u);
        const unsigned gen = old / nloc;
        if (old + 1u == (gen + 1u) * nloc) {
            __builtin_amdgcn_fence(__ATOMIC_RELEASE, "agent");
            asm volatile("s_waitcnt vmcnt(0)" ::: "memory");
            const unsigned og = xb_add(&bar[XB_TOP], 1u);
            const unsigned tg = og / nx;
            if (og + 1u == (tg + 1u) * nx) xb_add(&bar[XB_TOPGEN], 1u);
            else XB_SPIN(xb_ld(&bar[XB_TOPGEN]) == tg, bar);
            __builtin_amdgcn_fence(__ATOMIC_ACQUIRE, "agent");
            xb_add(&bar[XB_XGEN(b.x)], 1u);
            asm volatile("s_waitcnt vmcnt(0)" ::: "memory");
        } else {
            XB_SPIN(xb_ld(&bar[XB_XGEN(b.x)]) == gen, bar);
            __builtin_amdgcn_fence(__ATOMIC_ACQUIRE, "agent");
            asm volatile("s_waitcnt vmcnt(0)" ::: "memory");
        }
    }
    __syncthreads();
}

constexpr int N_PHASES = 22;
constexpr int RING_BYTES = 131072, MISC_OFF = RING_BYTES, LDS_BYTES = 147456;
__host__ __device__ inline bool phase_empty(int ph) { if (ph == 0 || ph == 21) return false; const int L = (ph - 1) / 5, s = (ph - 1) % 5; return s == 2 && (L % 3) != 0; }
struct KArgs { Params P; int ph_lo, ph_hi, use_bar, pad; };
constexpr int KA_PHLO = 8 * (N_IN + 2), KA_PHHI = KA_PHLO + 4, KA_USEBAR = KA_PHLO + 8;
__device__ __forceinline__ int KARG_I(int off) { return *(const int __attribute__((address_space(4)))*)(KARG() + off); }

__global__ void __launch_bounds__(512, 2) mk_fwd(KArgs args) {
    extern __shared__ __attribute__((aligned(16))) unsigned char lds_raw[];
    LAS unsigned char* lds = (LAS unsigned char*)lds_raw;
    const int wid_s = __builtin_amdgcn_readfirstlane(threadIdx.x >> 6);
    {
        volatile LAS unsigned* MISC = (volatile LAS unsigned*)(lds + MISC_OFF);
        if (threadIdx.x < 64) MISC[threadIdx.x] = 0u;
        __syncthreads();
        if (KARG_I(KA_USEBAR)) (void)xcd_barrier_post((unsigned*)(WSP() + WS_CTL) + 4096, MISC + 8);
    }
    bool first = true;
    for (int ph = KARG_I(KA_PHLO); ph < KARG_I(KA_PHHI); ++ph) {
        if (phase_empty(ph)) continue;
        if (!first && KARG_I(KA_USEBAR)) { XcdBarrier bar; bar.bar = (unsigned*)(WSP() + WS_CTL) + 4096; bar.x = xb_xcc_id(); bar.st = (volatile LAS unsigned*)(lds + MISC_OFF) + 8; xcd_barrier(bar); }
        first = false;
        const int G = gridDim.x, bx = blockIdx.x;
        if (ph == 0) { p0_phase(wid_s, bx, G, lds); continue; }
        if (ph == 21) { final_phase(wid_s, bx, G); continue; }
        const int layer = (ph - 1) / 5, st = (ph - 1) % 5, kind = layer % 3, j = layer / 3;
        if (st == 0) { norm_phase(wid_s, layer, bx, G); continue; }
        if (st == 1) {
            if (kind == 0) {
                EpiMlaIn e1{j};
                pg8::Gemm g{(const bf16*)(WSP() + WS_H), (const bf16*)(WSP() + WS_WMIN) + (size_t)j * 1792 * 1024, 0};
                pg8::StaticOrder S; S.init(MTOK, 1792, G, bx);
                pg8::gemm_phase<1024, false>(wid_s, lds, g, S, e1);
            } else {
                EpiGqaIn e1{kind};
                pg8::Gemm g{(const bf16*)(WSP() + WS_H), (const bf16*)(WSP() + (kind == 1 ? WS_WGIN : WS_WSIN)), 0};
                pg8::StaticOrder S; S.init(MTOK, 2560, G, bx);
                pg8::gemm_phase<1024, false>(wid_s, lds, g, S, e1);
            }
            continue;
        }
        if (st == 2) {
            { EpiMlaUq e2{0};
              pg8::Gemm g{(const bf16*)(WSP() + WS_CQ), (const bf16*)(WSP() + WS_WUQ) + (size_t)j * 1536 * 384, 0};
              pg8::StaticOrder S; S.init(MTOK, 1536, G, bx);
              pg8::gemm_phase<384, false>(wid_s, lds, g, S, e2); }
            { EpiMlaUkv e3{0};
              pg8::Gemm g{(const bf16*)(WSP() + WS_CKVA) + (size_t)j * LALL * 256, (const bf16*)(WSP() + WS_WUKVG) + (size_t)j * 2048 * 256, (long)(WS_WUKVP - WS_WUKVG)};
              pg8::StaticOrder S; S.init(LALL, 2048, G, G - 1 - bx);
              pg8::gemm_phase<256, true>(wid_s, lds, g, S, e3); }
            ckvfix_phase(wid_s, j, bx, G);
            continue;
        }
        if (st == 3) {
            unsigned char* ws = WSP();
            AttnArgs aa{};
            aa.kind = kind; aa.Q = (const bf16*)(ws + WS_Q); aa.Qr = (const bf16*)(ws + WS_QR); aa.SG = (const bf16*)(ws + WS_SG); aa.O = (bf16*)(ws + WS_H); aa.sink = INP(I_SINK);
            if (kind == 0) { aa.K = (const bf16*)(ws + WS_KALL); aa.Kr = (const bf16*)(ws + WS_KPEA) + (size_t)j * LALL * 32; aa.V = (const bf16*)(ws + WS_VALL); aa.kpitch = 1024; }
            else { aa.K = (const bf16*)(ws + WS_GK) + (size_t)(kind - 1) * LALL * 256; aa.Kr = nullptr; aa.V = (const bf16*)(ws + WS_GV) + (size_t)(kind - 1) * LALL * 256; aa.kpitch = 256; }
            attn_naive_phase(wid_s, aa, bx, G);
            continue;
        }
        {
            EpiOut eo{layer};
            pg8::Gemm g{(const bf16*)(WSP() + WS_H), (const bf16*)(WSP() + WS_WOUT) + (size_t)layer * 1024 * 1024, 0};
            pg8::StaticOrder S; S.init(MTOK, 1024, G, bx);
            pg8::gemm_phase<1024, false>(wid_s, lds, g, S, eo);
        }
    }
}

#ifndef MK_ONE_LAUNCH
#define MK_ONE_LAUNCH 1
#endif
extern "C" void kernel_launch(void* const* d_in, const int* in_sizes, int n_in, void* d_out, int out_size, void* d_ws, size_t ws_size, hipStream_t stream) {
    static int grid = 0;
    if (grid == 0) {
        if (n_in != N_IN || ws_size < WS_END || out_size != 25690112) { fprintf(stderr, "kernel_launch: unexpected shapes n_in %d ws %zu out %d\n", n_in, ws_size, out_size); grid = -1; return; }
        int dev = 0, cus = 0;
        if (hipGetDevice(&dev) != hipSuccess || hipDeviceGetAttribute(&cus, hipDeviceAttributeMultiprocessorCount, dev) != hipSuccess) { grid = -1; return; }
        if (hipFuncSetAttribute((const void*)mk_fwd, hipFuncAttributeMaxDynamicSharedMemorySize, LDS_BYTES) != hipSuccess) { fprintf(stderr, "kernel_launch: hipFuncSetAttribute failed\n"); grid = -1; return; }
        grid = cus;
    }
    if (grid < 0) return;
    (void)hipMemsetAsync((char*)d_ws + WS_CTL, 0, CTL_BYTES, stream);
    KArgs a{};
    for (int i = 0; i < N_IN; ++i) a.P.in[i] = (const float*)d_in[i];
    a.P.out = (float*)d_out; a.P.ws = (unsigned char*)d_ws;
#if MK_ONE_LAUNCH
    a.ph_lo = 0; a.ph_hi = N_PHASES; a.use_bar = 1;
    hipLaunchKernelGGL(mk_fwd, dim3(grid), dim3(512), LDS_BYTES, stream, a);
#else
    for (int ph = 0; ph < N_PHASES; ++ph) {
        if (phase_empty(ph)) continue;
        a.ph_lo = ph; a.ph_hi = ph + 1; a.use_bar = 0;
        hipLaunchKernelGGL(mk_fwd, dim3(grid), dim3(512), LDS_BYTES, stream, a);
    }
#endif
}
```

```cpp
#include <hip/hip_runtime.h>
#include <cstdint>
#include <cstdio>

typedef unsigned short bf16;
typedef float f32x4 __attribute__((ext_vector_type(4)));
typedef unsigned u32x4 __attribute__((ext_vector_type(4)));
typedef unsigned u32x2 __attribute__((ext_vector_type(2)));
#define LAS __attribute__((address_space(3)))

constexpr int D = 1024, NCTX = 8192, NLAT = 4096, MTOK = 12288, LALL = 14336;
constexpr float EPS = 1e-6f;
constexpr float LOG2E = 1.4426950408889634f;
constexpr float C2G = 0.125f * LOG2E;
constexpr float C2M = 0.10206207261596577f * LOG2E;

enum { I_XP = 0, I_XS, I_CCKV, I_CKPE, I_CGK, I_CGV, I_CSK, I_CSV, I_C, I_CCTX, I_NORMG, I_WADA, I_BADA, I_WOUT, I_MWIN, I_MQN, I_MWUQ, I_MKVN, I_MWUKV,
       I_GWIN, I_GQN, I_GKN, I_SWIN, I_SINK, I_FNG, N_IN };

constexpr size_t O_Y = 0, O_CKV = 12582912, O_KPE = 16777216, O_GK = 17301504, O_GV = 19398656, O_SK = 21495808, O_SV = 23592960;

constexpr size_t MiB = 1u << 20;
constexpr size_t WS_CTL = 0, CTL_BYTES = 1 * MiB;
constexpr size_t WS_MOD = 1 * MiB;
constexpr size_t WS_COSH = 1 * MiB + 512 * 1024;
constexpr size_t WS_SINH = WS_COSH + 128 * 1024;
constexpr size_t WS_COSR = WS_SINH + 128 * 1024;
constexpr size_t WS_SINR = WS_COSR + 64 * 1024;
constexpr size_t WS_SSKV = 2 * MiB;
constexpr size_t WS_SSQ = 2 * MiB + 512 * 1024;
constexpr size_t WS_WOUT = 3 * MiB;
constexpr size_t WS_WMIN = 11 * MiB;
constexpr size_t WS_WUQ = 18 * MiB;
constexpr size_t WS_WUKVG = 21 * MiB;
constexpr size_t WS_WUKVP = 23 * MiB;
constexpr size_t WS_WGIN = 25 * MiB;
constexpr size_t WS_WSIN = 30 * MiB;
constexpr size_t WS_H = 36 * MiB;
constexpr size_t WS_Q = 60 * MiB;
constexpr size_t WS_QR = 84 * MiB;
constexpr size_t WS_SG = 96 * MiB;
constexpr size_t WS_KALL = 120 * MiB;
constexpr size_t WS_VALL = 148 * MiB;
constexpr size_t WS_CQ = 176 * MiB;
constexpr size_t WS_CKVA = 185 * MiB;
constexpr size_t WS_KPEA = 199 * MiB;
constexpr size_t WS_GK = 201 * MiB;
constexpr size_t WS_GV = 215 * MiB;
constexpr size_t WS_END = 229 * MiB;

struct Params { const float* in[N_IN]; float* out; unsigned char* ws; };
typedef __attribute__((address_space(4))) const char* kaptr_t;
__device__ __forceinline__ kaptr_t KARG() { kaptr_t ka = (kaptr_t)__builtin_amdgcn_kernarg_segment_ptr(); asm volatile("" : "+s"(ka)); return ka; }
__device__ __forceinline__ const float* INP(int i) { return *(const float* const __attribute__((address_space(4)))*)(KARG() + 8 * i); }
__device__ __forceinline__ float* OUTP() { return *(float* const __attribute__((address_space(4)))*)(KARG() + 8 * N_IN); }
__device__ __forceinline__ unsigned char* WSP() { return *(unsigned char* const __attribute__((address_space(4)))*)(KARG() + 8 * (N_IN + 1)); }

__device__ __forceinline__ int vlaunder(int x) { asm volatile("" : "+v"(x)); return x; }
__device__ __forceinline__ int slaunder(int x) { asm volatile("" : "+s"(x)); return x; }
__device__ __forceinline__ int lane_id() { int l; asm volatile("v_mbcnt_lo_u32_b32 %0, -1, 0\n\tv_mbcnt_hi_u32_b32 %0, -1, %0" : "=v"(l)); return l; }
#define TID_FROM(wid_s) (slaunder(wid_s) * 64 + lane_id())
__device__ __forceinline__ unsigned f2bf(float f) { unsigned u = __builtin_bit_cast(unsigned, f); return (u + 0x7fffu + ((u >> 16) & 1u)) >> 16; }
__device__ __forceinline__ unsigned pk2(float lo, float hi) { return f2bf(lo) | (f2bf(hi) << 16); }
__device__ __forceinline__ float bflo(unsigned w) { return __builtin_bit_cast(float, w << 16); }
__device__ __forceinline__ float bfhi(unsigned w) { return __builtin_bit_cast(float, w & 0xffff0000u); }
__device__ __forceinline__ u32x4 pack8(const float* v) { u32x4 r; r.x = pk2(v[0], v[1]); r.y = pk2(v[2], v[3]); r.z = pk2(v[4], v[5]); r.w = pk2(v[6], v[7]); return r; }
template <int K> __device__ __forceinline__ float swz_xor(float v) { return __builtin_bit_cast(float, __builtin_amdgcn_ds_swizzle(__builtin_bit_cast(int, v), 0x1F | (K << 10))); }
__device__ __forceinline__ void x32_pair(float v, float& a, float& b) { a = v; b = v; asm volatile("s_nop 1\n\tv_permlane32_swap_b32 %0, %1\n\ts_nop 1" : "+v"(a), "+v"(b)); }
__device__ __forceinline__ float x32_sum(float v) { float a, b; x32_pair(v, a, b); return a + b; }
__device__ __forceinline__ float x32_max(float v) { float a, b; x32_pair(v, a, b); return fmaxf(a, b); }
__device__ __forceinline__ float wave_sum(float v) { v += swz_xor<1>(v); v += swz_xor<2>(v); v += swz_xor<4>(v); v += swz_xor<8>(v); v += swz_xor<16>(v); return x32_sum(v); }
__device__ __forceinline__ float wave_max(float v) { v = fmaxf(v, swz_xor<1>(v)); v = fmaxf(v, swz_xor<2>(v)); v = fmaxf(v, swz_xor<4>(v)); v = fmaxf(v, swz_xor<8>(v)); v = fmaxf(v, swz_xor<16>(v)); return x32_max(v); }
__device__ __forceinline__ float silu(float x) { return x / (1.f + __expf(-x)); }
__device__ __forceinline__ void rope8(float* v, const float* cs, const float* sn) {
    const f32x4 c = *(const f32x4*)cs, s = *(const f32x4*)sn;
#pragma unroll
    for (int i = 0; i < 4; ++i) { const float a = v[2 * i], b = v[2 * i + 1]; v[2 * i] = a * c[i] - b * s[i]; v[2 * i + 1] = a * s[i] + b * c[i]; }
}

__device__ __forceinline__ int wt_orig_base(int map, int nb) {
    switch (map) {
    case 0: return 32 * nb;
    case 1: { const int tile = nb >> 3, q = nb & 7, bj = q >> 2, wc = q & 3; return 256 * tile + 64 * wc + 32 * bj; }
    case 2: return nb < 8 ? 384 + 32 * nb : nb < 20 ? 32 * (nb - 8) : nb == 20 ? 640 : nb < 24 ? -1 : 672 + 32 * (nb - 24);
    case 3: if (nb < 32) return 96 * (nb >> 1) + 32 * (nb & 1); else return 96 * (nb - 32) + 64;
    default: if (nb < 32) return 128 * (nb >> 1) + 32 * (nb & 1); else { const int r = nb - 32; return 128 * (r >> 1) + 64 + 32 * (r & 1); }
    }
}
__device__ __forceinline__ void wt_item(const float* W, int K, int Norig, bf16* WT, const float* g, int map, int kb, int nb, LAS float* scr, int lane) {
    const int k0 = 64 * kb, ob = wt_orig_base(map, nb);
    if (ob >= 0) {
#pragma unroll 8
        for (int i = 0; i < 32; ++i) { const int kk = 2 * i + (lane >> 5); scr[kk * 33 + (lane & 31)] = W[(size_t)(k0 + kk) * Norig + ob + (lane & 31)]; }
    } else {
#pragma unroll 8
        for (int i = 0; i < 32; ++i) { const int kk = 2 * i + (lane >> 5); scr[kk * 33 + (lane & 31)] = 0.f; }
    }
    asm volatile("s_waitcnt lgkmcnt(0)" ::: "memory");
    const int c = lane & 7;
    float gs[8];
#pragma unroll
    for (int e = 0; e < 8; ++e) gs[e] = g ? g[k0 + 8 * c + e] : 1.f;
#pragma unroll
    for (int j = 0; j < 4; ++j) { const int n = (lane >> 3) + 8 * j; const LAS float* s = scr + (8 * c) * 33 + n;
        u32x4 o; o.x = pk2(s[0 * 33] * gs[0], s[1 * 33] * gs[1]); o.y = pk2(s[2 * 33] * gs[2], s[3 * 33] * gs[3]); o.z = pk2(s[4 * 33] * gs[4], s[5 * 33] * gs[5]); o.w = pk2(s[6 * 33] * gs[6], s[7 * 33] * gs[7]);
        *(u32x4*)(WT + (size_t)(32 * nb + n) * K + k0 + 8 * c) = o; }
    asm volatile("s_waitcnt lgkmcnt(0)" ::: "memory");
}
constexpr int WT_ITEMS = 2048 + 1792 + 576 + 512 + 512 + 2560;
__device__ __forceinline__ void wt_dispatch(int it, LAS float* scr, int lane) {
    unsigned char* ws = WSP(); int r = it;
    if (r < 2048) { const int i = r >> 9; r &= 511; wt_item(INP(I_WOUT) + (size_t)i * 1024 * 1024, 1024, 1024, (bf16*)(ws + WS_WOUT) + (size_t)i * 1024 * 1024, nullptr, 0, r / 32, r % 32, scr, lane); return; } r -= 2048;
    if (r < 1792) { const int j = r / 896; r %= 896; wt_item(INP(I_MWIN) + (size_t)j * 1024 * 1696, 1024, 1696, (bf16*)(ws + WS_WMIN) + (size_t)j * 1792 * 1024, nullptr, 2, r / 56, r % 56, scr, lane); return; } r -= 1792;
    if (r < 576) { const int j = r / 288; r %= 288; wt_item(INP(I_MWUQ) + (size_t)j * 384 * 1536, 384, 1536, (bf16*)(ws + WS_WUQ) + (size_t)j * 1536 * 384, INP(I_MQN) + j * 384, 3, r / 48, r % 48, scr, lane); return; } r -= 576;
    if (r < 512) { const int j = r / 256; r %= 256; wt_item(INP(I_MWUKV) + (size_t)j * 256 * 2048, 256, 2048, (bf16*)(ws + WS_WUKVG) + (size_t)j * 2048 * 256, INP(I_MKVN) + j * 256, 4, r / 64, r % 64, scr, lane); return; } r -= 512;
    if (r < 512) { const int j = r / 256; r %= 256; wt_item(INP(I_MWUKV) + (size_t)j * 256 * 2048, 256, 2048, (bf16*)(ws + WS_WUKVP) + (size_t)j * 2048 * 256, nullptr, 4, r / 64, r % 64, scr, lane); return; } r -= 512;
    if (r < 1280) { wt_item(INP(I_GWIN), 1024, 2560, (bf16*)(ws + WS_WGIN), nullptr, 1, r / 80, r % 80, scr, lane); return; } r -= 1280;
    wt_item(INP(I_SWIN), 1024, 2560, (bf16*)(ws + WS_WSIN), nullptr, 1, r / 80, r % 80, scr, lane);
}
__device__ __forceinline__ void adaln_item(int it, LAS unsigned char* lds, int tid) {
    LAS float* sv = (LAS float*)lds;
    LAS float* red = (LAS float*)(lds + 20480);
    const int i = it / 48, cg = it % 48;
    for (int idx = tid; idx < 5120; idx += 512) { const int v = idx >> 10, k = idx & 1023; const float x = v == 0 ? INP(I_CCTX)[k] : INP(I_C)[(v - 1) * 1024 + k]; sv[idx] = x / (1.f + expf(-x)); }
    __syncthreads();
    const int kr = tid >> 4, c4 = tid & 15;
    const float* wp = INP(I_WADA) + (size_t)i * 1024 * 3072 + cg * 64 + c4 * 4;
    f32x4 acc[5];
#pragma unroll
    for (int v = 0; v < 5; ++v) acc[v] = (f32x4){0.f, 0.f, 0.f, 0.f};
#pragma unroll 8
    for (int kk = 0; kk < 32; ++kk) { const int k = kk * 32 + kr; const f32x4 w = *(const f32x4*)(wp + (size_t)k * 3072);
#pragma unroll
        for (int v = 0; v < 5; ++v) acc[v] += w * sv[v * 1024 + k]; }
#pragma unroll
    for (int v = 0; v < 5; ++v) *(LAS f32x4*)(red + ((kr * 5 + v) * 64 + c4 * 4)) = acc[v];
    __syncthreads();
    if (tid < 320) { const int v = tid >> 6, col = tid & 63; float s = INP(I_BADA)[i * 3072 + cg * 64 + col];
#pragma unroll 8
        for (int r = 0; r < 32; ++r) s += red[(r * 5 + v) * 64 + col];
        ((float*)(WSP() + WS_MOD))[(size_t)(i * 5 + v) * 3072 + cg * 64 + col] = s; }
    __syncthreads();
}
__device__ __forceinline__ void p0_phase(int wid_s, int vb, int nvb, LAS unsigned char* lds) {
    vb = slaunder(vb); nvb = slaunder(nvb);
    const int tid = TID_FROM(wid_s), lane = tid & 63, wave = tid >> 6;
    for (int it = vb; it < 192; it += nvb) adaln_item(it, lds, tid);
    LAS float* scr = (LAS float*)(lds + wave * 16384);
    const int gw = vb * 8 + wave, NGW = nvb * 8;
    for (int it = gw; it < WT_ITEMS; it += NGW) wt_dispatch(it, scr, lane);
    const int gt = vb * 512 + tid, NGT = nvb * 512;
    unsigned char* ws = WSP();
    for (int it = gt; it < 409600; it += NGT) {
        int r = it; const float* src; bf16* dst;
        if (r < 131072) { const int row = r >> 5, ch = r & 31, b = row >> 10, j = (row >> 9) & 1, s = row & 511;
            src = INP(I_CCKV) + (size_t)row * 256 + ch * 8; dst = (bf16*)(ws + WS_CKVA) + ((size_t)j * LALL + 8192 + b * 1536 + s) * 256 + ch * 8; }
        else if ((r -= 131072) < 16384) { const int row = r >> 2, ch = r & 3, b = row >> 10, j = (row >> 9) & 1, s = row & 511;
            src = INP(I_CKPE) + (size_t)row * 32 + ch * 8; dst = (bf16*)(ws + WS_KPEA) + ((size_t)j * LALL + 8192 + b * 1536 + s) * 32 + ch * 8; }
        else { r -= 16384; const int which = r >> 16; r &= 65535; const int row = r >> 5, ch = r & 31, b = row >> 9, s = row & 511;
            src = (which == 0 ? INP(I_CGK) : which == 1 ? INP(I_CGV) : which == 2 ? INP(I_CSK) : INP(I_CSV)) + (size_t)row * 256 + ch * 8;
            dst = (bf16*)(ws + ((which & 1) ? WS_GV : WS_GK)) + ((size_t)(which >> 1) * LALL + 8192 + b * 1536 + s) * 256 + ch * 8; }
        const f32x4 a = *(const f32x4*)src, bq = *(const f32x4*)(src + 4);
        u32x4 o; o.x = pk2(a[0], a[1]); o.y = pk2(a[2], a[3]); o.z = pk2(bq[0], bq[1]); o.w = pk2(bq[2], bq[3]);
        *(u32x4*)dst = o;
    }
    for (int it = gt; it < 1024 * 48; it += NGT) {
        const int t = it / 48, e = it % 48; const float rowf = (float)(t >> 6), colf = (float)(t & 63);
        float ang; float* cd; float* sd;
        if (e < 32) { const float fr = powf(10000.f, -(float)(e & 15) / 16.f); ang = (e < 16 ? rowf : colf) * fr; cd = (float*)(ws + WS_COSH) + t * 32 + e; sd = (float*)(ws + WS_SINH) + t * 32 + e; }
        else { const int i = e - 32; const float fr = powf(10000.f, -(float)(i & 7) / 8.f); ang = (i < 8 ? rowf : colf) * fr; cd = (float*)(ws + WS_COSR) + t * 16 + i; sd = (float*)(ws + WS_SINR) + t * 16 + i; }
        const float n = rintf(ang * 0.15915494309189535f);
        float rr = fmaf(-n, 6.2831854820251465f, ang); rr = fmaf(-n, -1.7484555e-7f, rr);
        *cd = cosf(rr); *sd = sinf(rr);
    }
}

__device__ __forceinline__ const float* xrow_ptr(int layer, int row) {
    return layer == 0 ? (row < NCTX ? INP(I_XP) + (size_t)row * D : INP(I_XS) + (size_t)(row - NCTX) * D) : OUTP() + (size_t)row * D;
}
__device__ __forceinline__ void norm_phase(int wid_s, int layer, int vb, int nvb) {
    vb = slaunder(vb); nvb = slaunder(nvb); const int tid_ = TID_FROM(wid_s); const int lane = tid_ & 63, gw = vb * 8 + (tid_ >> 6), NGW = nvb * 8;
    const float* g = INP(I_NORMG) + layer * D; bf16* H = (bf16*)(WSP() + WS_H);
    for (int row = gw; row < MTOK; row += NGW) {
        const f32x4* xr = (const f32x4*)xrow_ptr(layer, row) + lane;
        const int v = row < NCTX ? 0 : 1 + ((row - NCTX) >> 10);
        const float* mod = (const float*)(WSP() + WS_MOD) + (size_t)(layer * 5 + v) * 3072;
        f32x4 x[4]; float ss = 0.f;
#pragma unroll
        for (int j = 0; j < 4; ++j) { x[j] = xr[64 * j]; ss += (x[j][0] * x[j][0] + x[j][1] * x[j][1]) + (x[j][2] * x[j][2] + x[j][3] * x[j][3]); }
        const float rstd = rsqrtf(wave_sum(ss) * (1.f / D) + EPS);
#pragma unroll
        for (int j = 0; j < 4; ++j) { const int col = 4 * lane + 256 * j;
            const f32x4 gg = *(const f32x4*)(g + col), sh = *(const f32x4*)(mod + col), sc = *(const f32x4*)(mod + 1024 + col);
            const f32x4 h = x[j] * rstd * gg * (sc + 1.f) + sh;
            u32x2 o; o.x = pk2(h[0], h[1]); o.y = pk2(h[2], h[3]);
            *(u32x2*)(H + (size_t)row * D + col) = o; }
    }
}
__device__ __forceinline__ void final_phase(int wid_s, int vb, int nvb) {
    vb = slaunder(vb); nvb = slaunder(nvb); const int tid_ = TID_FROM(wid_s); const int lane = tid_ & 63, gw = vb * 8 + (tid_ >> 6), NGW = nvb * 8;
    const float* g = INP(I_FNG);
    for (int row = gw; row < MTOK; row += NGW) {
        f32x4* xr = (f32x4*)(OUTP() + (size_t)row * D) + lane;
        f32x4 x[4]; float ss = 0.f;
#pragma unroll
        for (int j = 0; j < 4; ++j) { x[j] = xr[64 * j]; ss += (x[j][0] * x[j][0] + x[j][1] * x[j][1]) + (x[j][2] * x[j][2] + x[j][3] * x[j][3]); }
        const float rstd = rsqrtf(wave_sum(ss) * (1.f / D) + EPS);
#pragma unroll
        for (int j = 0; j < 4; ++j) xr[64 * j] = x[j] * rstd * *(const f32x4*)(g + 4 * lane + 256 * j);
    }
}
__device__ __forceinline__ void ckvfix_phase(int wid_s, int j, int vb, int nvb) {
    vb = slaunder(vb); nvb = slaunder(nvb); const int tid_ = TID_FROM(wid_s); const int lane = tid_ & 63, gw = vb * 8 + (tid_ >> 6), NGW = nvb * 8;
    const float* g = INP(I_MKVN) + j * 256; const float* SS = (const float*)(WSP() + WS_SSKV);
    for (int row = gw; row < NCTX; row += NGW) {
        const f32x4 ss = *(const f32x4*)(SS + row * 4);
        const float rstd = rsqrtf(((ss[0] + ss[1]) + (ss[2] + ss[3])) * (1.f / 256.f) + EPS);
        f32x4* p = (f32x4*)(OUTP() + O_CKV + ((size_t)((row >> 8) * 2 + j) * 256 + (row & 255)) * 256) + lane;
        *p = *p * rstd * *(const f32x4*)(g + 4 * lane);
    }
}

struct Unit { int pm, pn; };
typedef f32x4 Acc[2][2][4][2];
#define LOADV8(v, ai, bj, m) do { const f32x4 _a = acc[ai][bj][m][0], _b = acc[ai][bj][m][1]; v[0] = _a[0]; v[1] = _a[1]; v[2] = _a[2]; v[3] = _a[3]; v[4] = _b[0]; v[5] = _b[1]; v[6] = _b[2]; v[7] = _b[3]; } while (0)

struct EpiMlaIn {
    static constexpr bool PERM = true;
    int j;
    __device__ __forceinline__ void operator()(const Acc& acc, const Unit& u, int wr, int wc, int fr, int fq) const {
        unsigned char* ws = WSP(); float* out = OUTP();
        bf16* ckva = (bf16*)(ws + WS_CKVA) + (size_t)j * LALL * 256; bf16* kpea = (bf16*)(ws + WS_KPEA) + (size_t)j * LALL * 32; bf16* cq = (bf16*)(ws + WS_CQ); bf16* sg = (bf16*)(ws + WS_SG);
        float* outckv = out + O_CKV; float* outkpe = out + O_KPE; float* sskv = (float*)(ws + WS_SSKV); float* ssq = (float*)(ws + WS_SSQ);
        const float* cosR = (const float*)(ws + WS_COSR); const float* sinR = (const float*)(ws + WS_SINR);
#pragma unroll
        for (int ai = 0; ai < 2; ++ai)
#pragma unroll
            for (int m = 0; m < 4; ++m) {
                asm volatile("" ::: "memory");
                const int row = u.pm * 256 + ai * 128 + wr * 64 + m * 16 + fr;
                const bool lat = row >= NCTX; const int t = (row - NCTX) & 1023, b = (row - NCTX) >> 10;
                const int krow = lat ? NCTX + b * 1536 + 512 + t : row;
                const size_t orow = (size_t)((row >> 8) * 2 + j) * 256 + (row & 255);
                float v[2][8]; LOADV8(v[0], ai, 0, m); LOADV8(v[1], ai, 1, m);
                if (u.pn <= 2) {
                    float ss = 0.f;
#pragma unroll
                    for (int bj = 0; bj < 2; ++bj) { if (u.pn == 2 && bj == 1) break;
#pragma unroll
                        for (int i = 0; i < 8; ++i) ss += v[bj][i] * v[bj][i]; }
                    ss += swz_xor<16>(ss); ss = x32_sum(ss);
                    if (u.pn == 0) {
#pragma unroll
                        for (int bj = 0; bj < 2; ++bj) { const int lc = 128 * bj + 32 * wc + 8 * fq;
                            *(u32x4*)(ckva + (size_t)krow * 256 + lc) = pack8(v[bj]);
                            if (!lat) { float* o = outckv + orow * 256 + lc; *(f32x4*)o = acc[ai][bj][m][0]; *(f32x4*)(o + 4) = acc[ai][bj][m][1]; } }
                        if (fq == 0) sskv[row * 4 + wc] = ss;
                    } else if (u.pn == 1) {
#pragma unroll
                        for (int bj = 0; bj < 2; ++bj) *(u32x4*)(cq + (size_t)row * 384 + 128 * bj + 32 * wc + 8 * fq) = pack8(v[bj]);
                        if (fq == 0) ssq[row * 8 + wc] = ss;
                    } else {
                        *(u32x4*)(cq + (size_t)row * 384 + 256 + 32 * wc + 8 * fq) = pack8(v[0]);
                        if (fq == 0) ssq[row * 8 + 4 + wc] = ss;
                        if (wc == 0) {
                            if (!lat) { float* o = outkpe + orow * 32 + 8 * fq; *(f32x4*)o = acc[ai][1][m][0]; *(f32x4*)(o + 4) = acc[ai][1][m][1]; }
                            else rope8(v[1], cosR + t * 16 + 4 * fq, sinR + t * 16 + 4 * fq);
                            *(u32x4*)(kpea + (size_t)krow * 32 + 8 * fq) = pack8(v[1]);
                        }
                    }
                } else {
#pragma unroll
                    for (int bj = 0; bj < 2; ++bj) {
#pragma unroll
                        for (int i = 0; i < 8; ++i) v[bj][i] = silu(v[bj][i]);
                        *(u32x4*)(sg + (size_t)row * D + (u.pn - 3) * 256 + 128 * bj + 32 * wc + 8 * fq) = pack8(v[bj]); }
                }
            }
    }
};
struct EpiMlaUq {
    static constexpr bool PERM = true;
    int dummy;
    __device__ __forceinline__ void operator()(const Acc& acc, const Unit& u, int wr, int wc, int fr, int fq) const {
        unsigned char* ws = WSP();
        bf16* qn = (bf16*)(ws + WS_Q); bf16* qr = (bf16*)(ws + WS_QR); const float* ssq = (const float*)(ws + WS_SSQ);
        const float* cosR = (const float*)(ws + WS_COSR); const float* sinR = (const float*)(ws + WS_SINR);
#pragma unroll
        for (int ai = 0; ai < 2; ++ai)
#pragma unroll
            for (int m = 0; m < 4; ++m) {
                asm volatile("" ::: "memory");
                const int row = u.pm * 256 + ai * 128 + wr * 64 + m * 16 + fr;
                const bool lat = row >= NCTX; const int t = (row - NCTX) & 1023;
                const f32x4 s0 = *(const f32x4*)(ssq + row * 8), s1 = *(const f32x4*)(ssq + row * 8 + 4);
                const float rstd = rsqrtf((((s0[0] + s0[1]) + (s0[2] + s0[3])) + ((s1[0] + s1[1]) + (s1[2] + s1[3]))) * (1.f / 384.f) + EPS) * C2M;
#pragma unroll
                for (int bj = 0; bj < 2; ++bj) { float v[8]; LOADV8(v, ai, bj, m);
#pragma unroll
                    for (int i = 0; i < 8; ++i) v[i] *= rstd;
                    const int lc = 128 * bj + 32 * wc + 8 * fq;
                    if (u.pn < 4) *(u32x4*)(qn + (size_t)row * D + 256 * u.pn + lc) = pack8(v);
                    else { const int pr = 256 * (u.pn - 4) + lc; if (lat) rope8(v, cosR + t * 16 + ((pr & 31) >> 1), sinR + t * 16 + ((pr & 31) >> 1));
                        *(u32x4*)(qr + (size_t)row * 512 + pr) = pack8(v); } }
            }
    }
};
__device__ __forceinline__ bool ukv_cache_tile(int pm) { return pm >= 32 && ((pm - 32) % 6) < 2; }
struct EpiMlaUkv {
    static constexpr bool PERM = true;
    int dummy;
    __device__ __forceinline__ void operator()(const Acc& acc, const Unit& u, int wr, int wc, int fr, int fq) const {
        unsigned char* ws = WSP();
        bf16* kall = (bf16*)(ws + WS_KALL); bf16* vall = (bf16*)(ws + WS_VALL); const float* sskv = (const float*)(ws + WS_SSKV);
        const bool cache = ukv_cache_tile(u.pm);
#pragma unroll
        for (int ai = 0; ai < 2; ++ai)
#pragma unroll
            for (int m = 0; m < 4; ++m) {
                asm volatile("" ::: "memory");
                const int krow = u.pm * 256 + ai * 128 + wr * 64 + m * 16 + fr;
                float rstd = 1.f;
                if (!cache) { int trow = krow; if (krow >= NCTX) { const int b = (krow - NCTX) / 1536, p = (krow - NCTX) % 1536; trow = NCTX + b * 1024 + (p - 512); }
                    const f32x4 ss = *(const f32x4*)(sskv + trow * 4); rstd = rsqrtf(((ss[0] + ss[1]) + (ss[2] + ss[3])) * (1.f / 256.f) + EPS); }
#pragma unroll
                for (int bj = 0; bj < 2; ++bj) { float v[8]; LOADV8(v, ai, bj, m);
#pragma unroll
                    for (int i = 0; i < 8; ++i) v[i] *= rstd;
                    const int lc = 128 * bj + 32 * wc + 8 * fq;
                    if (u.pn < 4) *(u32x4*)(kall + (size_t)krow * D + 256 * u.pn + lc) = pack8(v);
                    else *(u32x4*)(vall + (size_t)krow * D + 256 * (u.pn - 4) + lc) = pack8(v); }
            }
    }
};
struct EpiGqaIn {
    static constexpr bool PERM = true;
    int kind;
    __device__ __forceinline__ void operator()(const Acc& acc, const Unit& u, int wr, int wc, int fr, int fq) const {
        unsigned char* ws = WSP(); float* out = OUTP();
        bf16* q = (bf16*)(ws + WS_Q); bf16* sg = (bf16*)(ws + WS_SG);
        bf16* gk = (bf16*)(ws + WS_GK) + (size_t)(kind - 1) * LALL * 256; bf16* gv = (bf16*)(ws + WS_GV) + (size_t)(kind - 1) * LALL * 256;
        float* outk = out + (kind == 1 ? O_GK : O_SK); float* outv = out + (kind == 1 ? O_GV : O_SV);
        const float* cosH = (const float*)(ws + WS_COSH); const float* sinH = (const float*)(ws + WS_SINH);
#pragma unroll
        for (int ai = 0; ai < 2; ++ai)
#pragma unroll
            for (int m = 0; m < 4; ++m) {
                asm volatile("" ::: "memory");
                const int row = u.pm * 256 + ai * 128 + wr * 64 + m * 16 + fr;
                const bool lat = row >= NCTX; const int t = (row - NCTX) & 1023, b = (row - NCTX) >> 10;
                const int krow = lat ? NCTX + b * 1536 + 512 + t : row;
                float v[2][8]; LOADV8(v[0], ai, 0, m); LOADV8(v[1], ai, 1, m);
                if (u.pn <= 4) {
                    if (kind == 1) {
                        float ss = 0.f;
#pragma unroll
                        for (int bj = 0; bj < 2; ++bj)
#pragma unroll
                            for (int i = 0; i < 8; ++i) ss += v[bj][i] * v[bj][i];
                        ss += swz_xor<16>(ss); ss = x32_sum(ss);
                        const float rstd = rsqrtf(ss * (1.f / 64.f) + EPS); const float* g = u.pn < 4 ? INP(I_GQN) : INP(I_GKN);
#pragma unroll
                        for (int bj = 0; bj < 2; ++bj) { const f32x4 g0 = *(const f32x4*)(g + 32 * bj + 8 * fq), g1 = *(const f32x4*)(g + 32 * bj + 8 * fq + 4);
#pragma unroll
                            #ifdef PROBE_NOG
                            for (int i = 0; i < 4; ++i) { v[bj][i] *= rstd * (u.pn == 4 ? 1.f : g0[i]); v[bj][4 + i] *= rstd * (u.pn == 4 ? 1.f : g1[i]); } }
#else
                            for (int i = 0; i < 4; ++i) { v[bj][i] *= rstd * g0[i]; v[bj][4 + i] *= rstd * g1[i]; } }
#endif
                    }
#pragma unroll
                    for (int bj = 0; bj < 2; ++bj) { const int d0 = 32 * bj + 8 * fq;
                        if (u.pn == 4 && !lat) { float* o = outk + (size_t)row * 256 + wc * 64 + d0; *(f32x4*)o = (f32x4){v[bj][0], v[bj][1], v[bj][2], v[bj][3]}; *(f32x4*)(o + 4) = (f32x4){v[bj][4], v[bj][5], v[bj][6], v[bj][7]}; }
                        if (lat) rope8(v[bj], cosH + t * 32 + (d0 >> 1), sinH + t * 32 + (d0 >> 1));
                        if (u.pn < 4) {
#pragma unroll
                            for (int i = 0; i < 8; ++i) v[bj][i] *= C2G;
                            *(u32x4*)(q + (size_t)row * D + (4 * u.pn + wc) * 64 + d0) = pack8(v[bj]);
                        } else *(u32x4*)(gk + (size_t)krow * 256 + wc * 64 + d0) = pack8(v[bj]); }
                } else if (u.pn == 5) {
#pragma unroll
                    for (int bj = 0; bj < 2; ++bj) { const int d0 = 32 * bj + 8 * fq;
                        if (!lat) { float* o = outv + (size_t)row * 256 + wc * 64 + d0; *(f32x4*)o = acc[ai][bj][m][0]; *(f32x4*)(o + 4) = acc[ai][bj][m][1]; }
                        *(u32x4*)(gv + (size_t)krow * 256 + wc * 64 + d0) = pack8(v[bj]); }
                } else {
#pragma unroll
                    for (int bj = 0; bj < 2; ++bj) {
#pragma unroll
                        for (int i = 0; i < 8; ++i) v[bj][i] = silu(v[bj][i]);
                        *(u32x4*)(sg + (size_t)row * D + (u.pn - 6) * 256 + 64 * wc + 32 * bj + 8 * fq) = pack8(v[bj]); }
                }
            }
    }
};
struct EpiOut {
    static constexpr bool PERM = false;
    int layer;
    __device__ __forceinline__ void operator()(const Acc& acc, const Unit& u, int wr, int wc, int fr, int fq) const {
        float* out = OUTP(); const float* mod = (const float*)(WSP() + WS_MOD);
        const int vv = u.pm < 32 ? 0 : 1 + ((u.pm - 32) >> 2);
        const float* gate = mod + (size_t)(layer * 5 + vv) * 3072 + 2048;
#pragma unroll
        for (int ai = 0; ai < 2; ++ai)
#pragma unroll
            for (int m = 0; m < 4; ++m) {
                asm volatile("" ::: "memory");
                const int row = u.pm * 256 + ai * 128 + wr * 64 + m * 16 + fr;
                const float* base = layer == 0 ? (row < NCTX ? INP(I_XP) + (size_t)row * D : INP(I_XS) + (size_t)(row - NCTX) * D) : out + (size_t)row * D;
#pragma unroll
                for (int bj = 0; bj < 2; ++bj)
#pragma unroll
                    for (int n = 0; n < 2; ++n) { const int col = 256 * u.pn + 128 * bj + 32 * wc + 16 * n + 4 * fq;
                        #ifdef PROBE_ZERO_MASK
                        *(f32x4*)(out + (size_t)row * D + col) = ((PROBE_ZERO_MASK >> layer) & 1) ? *(const f32x4*)(base + col) : *(const f32x4*)(base + col) + *(const f32x4*)(gate + col) * acc[ai][bj][m][n]; }
#else
                        *(f32x4*)(out + (size_t)row * D + col) = *(const f32x4*)(base + col) + *(const f32x4*)(gate + col) * acc[ai][bj][m][n]; }
#endif
            }
    }
};

namespace pg8 {
typedef short bf16x8 __attribute__((ext_vector_type(8)));
constexpr int BM = 256, BK = 64, HALF = 128, HTB = HALF * BK * 2, STAGE_BYTES = 8 * HTB, NXCD = 8, WGM = 8;
__host__ __device__ __forceinline__ int lds_byte(int r, int c) { const int st = (r >> 4) * 2 + (c >> 5), rr = r & 15, cc = c & 31, ob = rr * 64 + cc * 2; return st * 1024 + (ob ^ (((ob >> 9) & 1) << 5)); }
__host__ __device__ __forceinline__ void stage_rc(int b, int& R, int& C) { const int st = b / 1024, sb = b % 1024, swz = sb ^ (((sb >> 9) & 1) << 5); R = (st >> 1) * 16 + swz / 64; C = (st & 1) * 32 + (swz % 64) / 2; }
__host__ __device__ __forceinline__ int perm32(int rho) { const int n = rho >> 4, i = rho & 15; return 8 * (i >> 2) + 4 * n + (i & 3); }
struct Gemm { const bf16* A; const bf16* Bt; long alt_delta; };
template <bool ALT> __device__ __forceinline__ const char* bbase(const Gemm& g, const Unit& u) { if constexpr (ALT) return (const char*)g.Bt + (ukv_cache_tile(u.pm) ? g.alt_delta : 0l); else return (const char*)g.Bt; }
struct StaticOrder {
    int nM, nN, nwg, G, c;
    __host__ __device__ void init(int M, int N, int G_, int c_) { nM = M / BM; nN = N / BM; nwg = nM * nN; G = G_; c = c_; }
    __host__ __device__ bool next(int i, Unit& u) const {
        const long L = (long)i * G + c; if (L >= nwg) return false;
        int wgid = (int)L; { const int q = nwg / NXCD, r = nwg % NXCD, xcd = wgid % NXCD, off = wgid / NXCD; wgid = (xcd < r ? xcd * (q + 1) : r * (q + 1) + (xcd - r) * q) + off; }
        const int nig = WGM * nN, gid = wgid / nig, fm = gid * WGM, gsz = (nM - fm) < WGM ? (nM - fm) : WGM;
        u.pm = fm + ((wgid % nig) % gsz); u.pn = (wgid % nig) / gsz; return true;
    }
};
template <int K, bool ALT, class Epi, class Sched>
__device__ __forceinline__ void gemm_phase(int wid_s, LAS unsigned char* lds, const Gemm g, const Sched& S, const Epi& E) {
    const int wid = slaunder(wid_s), lane = lane_id(), tid = wid * 64 + lane, wr = wid >> 2, wc = wid & 3, fr = lane & 15, fq = lane >> 4;
    constexpr int nt = K / BK;
    unsigned voffA[2], voffB[2];
#pragma unroll
    for (int i = 0; i < 2; ++i) { int R, C; stage_rc(tid * 16 + i * 8192, R, C); const int Rb = Epi::PERM ? ((R & ~31) + perm32(R & 31)) : R;
        voffA[i] = (unsigned)(R * K + C) * 2u; voffB[i] = (unsigned)(Rb * K + C) * 2u; }
    constexpr size_t kstep = (size_t)(BK * 2);
    constexpr size_t hstep = (size_t)HALF * K * 2;
    constexpr size_t tstep = 2 * hstep;
    const unsigned ldsw = (unsigned)wid * 1024u;
    const int aoff = lds_byte(wr * 64 + fr, fq * 8), boff = lds_byte(wc * 32 + fr, fq * 8);
#define PG8_SA(b, h) (((b) * 2 + (h)) * HTB)
#define PG8_SB(b, h) ((4 + (b) * 2 + (h)) * HTB)
#define PG8_STAGE(bufoff, gbase, voff) do { _Pragma("unroll") for (int _i = 0; _i < 2; ++_i) \
        __builtin_amdgcn_global_load_lds((const unsigned*)((const char*)(gbase) + (voff)[_i]), (LAS unsigned*)(lds + (bufoff) + ldsw + _i * 8192), 16, 0, 0); } while (0)
#define PG8_LDA(dst, b, h) do { _Pragma("unroll") for (int m = 0; m < 4; ++m) _Pragma("unroll") for (int k = 0; k < 2; ++k) dst[m][k] = *(const LAS bf16x8*)(lds + PG8_SA(b, h) + aoff + m * 2048 + k * 1024); } while (0)
#define PG8_LDB(dst, b, h) do { _Pragma("unroll") for (int n = 0; n < 2; ++n) _Pragma("unroll") for (int k = 0; k < 2; ++k) dst[n][k] = *(const LAS bf16x8*)(lds + PG8_SB(b, h) + boff + n * 2048 + k * 1024); } while (0)
#define PG8_MMA(ai, bj, At, Bt) do { __builtin_amdgcn_s_setprio(1); _Pragma("unroll") for (int m = 0; m < 4; ++m) _Pragma("unroll") for (int n = 0; n < 2; ++n) _Pragma("unroll") for (int k = 0; k < 2; ++k) \
        acc[ai][bj][m][n] = __builtin_amdgcn_mfma_f32_16x16x32_bf16(Bt[n][k], At[m][k], acc[ai][bj][m][n], 0, 0, 0); __builtin_amdgcn_s_setprio(0); } while (0)
#define PG8_WAIT_V(n) asm volatile("s_waitcnt vmcnt(" #n ")" ::: "memory")
#define PG8_WAIT_L(n) asm volatile("s_waitcnt lgkmcnt(" #n ")" ::: "memory")
#define PG8_BAR __builtin_amdgcn_s_barrier()
#define PG8_SCHED __builtin_amdgcn_sched_barrier(0)
    Unit cur, nxt; int ui = 0;
    if (!S.next(0, cur)) return;
    f32x4 acc[2][2][4][2];
#pragma unroll
    for (int a = 0; a < 2; ++a)
#pragma unroll
        for (int b = 0; b < 2; ++b)
#pragma unroll
            for (int m = 0; m < 4; ++m)
#pragma unroll
                for (int n = 0; n < 2; ++n) acc[a][b][m][n] = (f32x4){0.f, 0.f, 0.f, 0.f};
    bf16x8 At[4][2], B0[2][2], B1[2][2];
    const char* cA = (const char*)g.A + (size_t)cur.pm * tstep; const char* cB = bbase<ALT>(g, cur) + (size_t)cur.pn * tstep;
    PG8_STAGE(PG8_SB(0, 0), cB, voffB); PG8_STAGE(PG8_SB(0, 1), cB + hstep, voffB); PG8_STAGE(PG8_SA(0, 0), cA, voffA); PG8_STAGE(PG8_SA(0, 1), cA + hstep, voffA);
    if (wr == 1) PG8_BAR;
    PG8_WAIT_V(2); PG8_BAR;
    PG8_STAGE(PG8_SB(1, 0), cB + kstep, voffB); PG8_STAGE(PG8_SA(1, 0), cA + kstep, voffA); PG8_STAGE(PG8_SB(1, 1), cB + hstep + kstep, voffB);
    PG8_WAIT_V(6); PG8_BAR;
    for (;;) {
        const bool has_next = S.next(ui + 1, nxt);
        const char* nA = has_next ? (const char*)g.A + (size_t)nxt.pm * tstep : cA; const char* nB = has_next ? bbase<ALT>(g, nxt) + (size_t)nxt.pn * tstep : cB;
#pragma unroll 1
        for (int t = 0; t < nt; t += 2) {
            const bool last = (t == nt - 2);
            const char* a1 = cA + (size_t)(t + 1) * kstep;
            const char* a2 = last ? nA : cA + (size_t)(t + 2) * kstep; const char* b2 = last ? nB : cB + (size_t)(t + 2) * kstep;
            const char* a3 = a2 + kstep; const char* b3 = b2 + kstep;
            PG8_LDB(B0, 0, 0); PG8_LDB(B1, 0, 1); PG8_SCHED; PG8_LDA(At, 0, 0); PG8_STAGE(PG8_SA(1, 1), a1 + hstep, voffA);
            PG8_WAIT_V(8); PG8_WAIT_L(0); PG8_BAR; PG8_MMA(0, 0, At, B0); PG8_MMA(0, 1, At, B1); PG8_BAR; PG8_SCHED;
            PG8_LDA(At, 0, 1); PG8_STAGE(PG8_SB(0, 0), b2, voffB); PG8_STAGE(PG8_SB(0, 1), b2 + hstep, voffB); PG8_STAGE(PG8_SA(0, 0), a2, voffA);
            PG8_WAIT_V(8); PG8_WAIT_L(0); PG8_BAR; PG8_MMA(1, 0, At, B0); PG8_MMA(1, 1, At, B1); PG8_BAR; PG8_SCHED;
            PG8_LDB(B0, 1, 0); PG8_LDB(B1, 1, 1); PG8_SCHED; PG8_LDA(At, 1, 0); PG8_STAGE(PG8_SA(0, 1), a2 + hstep, voffA);
            PG8_WAIT_V(8); PG8_WAIT_L(0); PG8_BAR; PG8_MMA(0, 0, At, B0); PG8_MMA(0, 1, At, B1); PG8_BAR; PG8_SCHED;
            PG8_LDA(At, 1, 1); PG8_STAGE(PG8_SB(1, 0), b3, voffB); PG8_STAGE(PG8_SB(1, 1), b3 + hstep, voffB); PG8_STAGE(PG8_SA(1, 0), a3, voffA);
            PG8_WAIT_V(8); PG8_WAIT_L(0); PG8_BAR; PG8_MMA(1, 0, At, B0); PG8_MMA(1, 1, At, B1); PG8_BAR; PG8_SCHED;
        }
        if (wr == 0) PG8_BAR;
        { const int l2 = lane_id(); E(acc, cur, wid >> 2, wid & 3, l2 & 15, l2 >> 4); }
        if (!has_next) break;
#pragma unroll
        for (int a = 0; a < 2; ++a)
#pragma unroll
            for (int b = 0; b < 2; ++b)
#pragma unroll
                for (int m = 0; m < 4; ++m)
#pragma unroll
                    for (int n = 0; n < 2; ++n) acc[a][b][m][n] = (f32x4){0.f, 0.f, 0.f, 0.f};
        cur = nxt; cA = nA; cB = nB; ++ui;
        if (wr == 1) PG8_BAR;
    }
    PG8_WAIT_V(0);
    PG8_BAR;
#undef PG8_SA
#undef PG8_SB
#undef PG8_STAGE
#undef PG8_LDA
#undef PG8_LDB
#undef PG8_MMA
#undef PG8_WAIT_V
#undef PG8_WAIT_L
#undef PG8_BAR
#undef PG8_SCHED
}
}

namespace att {
typedef short bf16x8 __attribute__((ext_vector_type(8)));
typedef short s16x4 __attribute__((ext_vector_type(4)));
typedef float f32x16 __attribute__((ext_vector_type(16)));
constexpr int KSLOT = 12288, VSLOT = 8192;
constexpr int L_K = 0, L_V = 2 * KSLOT, L_WS = L_V + 2 * VSLOT, L_OST = L_WS + 8 * 256, L_END = L_OST + 8 * 4096;
constexpr float THR = 8.f;
__device__ __forceinline__ int crow(int r, int hi) { return (r & 3) + 8 * (r >> 2) + 4 * hi; }
__device__ __forceinline__ void glds16(const void* gsrc, unsigned lds_dst) { unsigned keep;
    asm volatile("s_mov_b32 %0, m0\n\ts_mov_b32 m0, %2\n\ts_nop 0\n\tglobal_load_lds_dwordx4 %1, off\n\ts_mov_b32 m0, %0" : "=&s"(keep) : "v"(gsrc), "s"(lds_dst) : "memory"); }
typedef float f32x2_t __attribute__((ext_vector_type(2))); typedef __bf16 bf16x2_t __attribute__((ext_vector_type(2)));
__device__ __forceinline__ unsigned cvtpk(float lo, float hi) { f32x2_t v = {lo, hi}; bf16x2_t b = __builtin_convertvector(v, bf16x2_t); return __builtin_bit_cast(unsigned, b); }
#define ATT_WAIT_BAR() asm volatile("s_waitcnt vmcnt(0) lgkmcnt(0)\n\ts_barrier" ::: "memory")

struct ALayer { const bf16 *Q, *Qr, *K, *Kr, *V, *SG; bf16* O; int kpitch; const float* sink; };
struct AUnit { int qrow0, krow0, ntiles, jump, swa, qpos0, hq0, gqa; };

template <int NQ>
__device__ __forceinline__ void attn_unit(const ALayer& A, const AUnit& U, LAS unsigned char* shm, int wid, int lane) {
    const int r32 = lane & 31, hi = lane >> 5;
    const int hq = U.gqa ? U.hq0 + (wid >> 1) : U.hq0;
    const int qsub = U.gqa ? 32 * (wid & 1) : 32 * wid;
    const int qrow = U.qrow0 + qsub;
    const int kvcol = U.gqa ? (U.hq0 >> 2) * 64 : U.hq0 * 64;
    const int kp = A.kpitch;
    const unsigned lds0 = (unsigned)(size_t)shm;
    const bf16* ksrc = A.K + (size_t)lane * kp + kvcol + wid * 8;
    const bf16* krsrc = A.Kr + (size_t)lane * 32 + (wid & 3) * 8;
    const bf16* vsrc = A.V + (size_t)(16 * (wid & 3) + (lane >> 2)) * kp + kvcol + (wid >> 2) * 32 + (lane & 3) * 8;
#define ATT_PHYS(t) ((t) + ((t) >= 8 ? U.jump : 0))
#define ATT_ISSUE(t, slot) do { const size_t kr_ = (size_t)(U.krow0 + 64 * ATT_PHYS(t)); \
        glds16(ksrc + kr_ * kp, (unsigned)__builtin_amdgcn_readfirstlane(lds0 + L_K + (slot) * KSLOT + wid * 1024)); \
        if (NQ == 6 && wid < 4) glds16(krsrc + kr_ * 32, (unsigned)__builtin_amdgcn_readfirstlane(lds0 + L_K + (slot) * KSLOT + (8 + wid) * 1024)); \
        glds16(vsrc + kr_ * kp, (unsigned)__builtin_amdgcn_readfirstlane(lds0 + L_V + (slot) * VSLOT + wid * 1024)); } while (0)
    ATT_ISSUE(0, 0);
    bf16x8 qr[NQ];
#pragma unroll
    for (int d0 = 0; d0 < 4; ++d0) qr[d0] = *(const bf16x8*)(A.Q + (size_t)(qrow + r32) * D + hq * 64 + d0 * 16 + hi * 8);
    if (NQ == 6) {
#pragma unroll
        for (int e = 0; e < NQ - 4; ++e) qr[4 + e] = *(const bf16x8*)(A.Qr + (size_t)(qrow + r32) * 512 + hq * 32 + e * 16 + hi * 8);
    }
    LAS float* wsf = (LAS float*)(shm + L_WS) + wid * 64;
    float mhat = 0.f, l = 0.f;
    f32x16 o[2]; f32x16 negm;
#pragma unroll
    for (int r = 0; r < 16; ++r) { o[0][r] = 0.f; o[1][r] = 0.f; negm[r] = 0.f; }
    ATT_WAIT_BAR();
    const int NT = U.ntiles;
    for (int t = 0; t < NT; ++t) {
        const int slot = t & 1;
        if (t + 1 < NT) ATT_ISSUE(t + 1, slot ^ 1);
        f32x16 p0, p1;
        { const LAS unsigned char* kb = shm + L_K + slot * KSLOT + hi * 1024 + r32 * 16;
#pragma unroll
          for (int d0 = 0; d0 < NQ; ++d0) {
              const bf16x8 b0 = *(const LAS bf16x8*)(kb + d0 * 2048), b1 = *(const LAS bf16x8*)(kb + d0 * 2048 + 512);
              if (d0 == 0) { p0 = __builtin_amdgcn_mfma_f32_32x32x16_bf16(b0, qr[0], negm, 0, 0, 0); p1 = __builtin_amdgcn_mfma_f32_32x32x16_bf16(b1, qr[0], negm, 0, 0, 0); }
              else { p0 = __builtin_amdgcn_mfma_f32_32x32x16_bf16(b0, qr[d0], p0, 0, 0, 0); p1 = __builtin_amdgcn_mfma_f32_32x32x16_bf16(b1, qr[d0], p1, 0, 0, 0); } } }
        if (U.swa && t >= 8) {
            const int dbase = 64 * (ATT_PHYS(t) - 8) + 4 * hi - (U.qpos0 + qsub + r32);
#pragma unroll
            for (int r = 0; r < 16; ++r) { const int d = dbase + (r & 3) + 8 * (r >> 2);
                if (d > 128 || d < -128) p0[r] = -INFINITY;
                if (d + 32 > 128 || d + 32 < -128) p1[r] = -INFINITY; }
        }
        float rm = fmaxf(p0[0], p1[0]);
#pragma unroll
        for (int r = 1; r < 16; ++r) rm = fmaxf(rm, fmaxf(p0[r], p1[r]));
        rm = x32_max(rm);
        bool resc = false;
        if (t == 0 || __any(rm > THR)) {
            const float dl = t == 0 ? rm : fmaxf(rm, 0.f);
            mhat += dl;
#pragma unroll
            for (int r = 0; r < 16; ++r) { p0[r] -= dl; p1[r] -= dl; negm[r] = -mhat; }
            if (t != 0) { const float f = __builtin_amdgcn_exp2f(-dl); l *= f; if (hi == 0) wsf[r32] = f; resc = true; }
        }
        float sacc = 0.f;
#pragma unroll
        for (int r = 0; r < 16; ++r) { p0[r] = __builtin_amdgcn_exp2f(p0[r]); p1[r] = __builtin_amdgcn_exp2f(p1[r]); sacc += p0[r] + p1[r]; }
        l += sacc;
        u32x4 pw0, pw1, pw2, pw3;
        pw0 = (u32x4){cvtpk(p0[0], p0[1]), cvtpk(p0[2], p0[3]), cvtpk(p0[4], p0[5]), cvtpk(p0[6], p0[7])};
        pw1 = (u32x4){cvtpk(p0[8], p0[9]), cvtpk(p0[10], p0[11]), cvtpk(p0[12], p0[13]), cvtpk(p0[14], p0[15])};
        pw2 = (u32x4){cvtpk(p1[0], p1[1]), cvtpk(p1[2], p1[3]), cvtpk(p1[4], p1[5]), cvtpk(p1[6], p1[7])};
        pw3 = (u32x4){cvtpk(p1[8], p1[9]), cvtpk(p1[10], p1[11]), cvtpk(p1[12], p1[13]), cvtpk(p1[14], p1[15])};
        if (resc) {
            asm volatile("s_waitcnt lgkmcnt(0)" ::: "memory");
#pragma unroll
            for (int g4 = 0; g4 < 4; ++g4) { const f32x4 fv = *(const LAS f32x4*)(wsf + 8 * g4 + 4 * hi);
#pragma unroll
                for (int j = 0; j < 4; ++j) { o[0][4 * g4 + j] *= fv[j]; o[1][4 * g4 + j] *= fv[j]; } }
        }
        { const int vb = (int)(lds0 + L_V + slot * VSLOT) + ((lane >> 4) & 1) * 32 + (lane & 3) * 8 + (4 * hi + ((lane & 15) >> 2)) * 64;
#pragma unroll
          for (int d0 = 0; d0 < 2; ++d0) { s16x4 lo[4], hh[4];
#pragma unroll
              for (int ks = 0; ks < 4; ++ks) {
                  asm volatile("ds_read_b64_tr_b16 %0,%1 offset:%c2" : "=&v"(lo[ks]) : "v"(vb), "i"(d0 * 4096 + ks * 1024) : "memory");
                  asm volatile("ds_read_b64_tr_b16 %0,%1 offset:%c2" : "=&v"(hh[ks]) : "v"(vb), "i"(d0 * 4096 + ks * 1024 + 512) : "memory"); }
              asm volatile("s_waitcnt lgkmcnt(0)" ::: "memory"); __builtin_amdgcn_sched_barrier(0);
#define ATT_PK(k) (bf16x8){lo[k][0], lo[k][1], lo[k][2], lo[k][3], hh[k][0], hh[k][1], hh[k][2], hh[k][3]}
              o[d0] = __builtin_amdgcn_mfma_f32_32x32x16_bf16(__builtin_bit_cast(bf16x8, pw0), ATT_PK(0), o[d0], 0, 0, 0);
              o[d0] = __builtin_amdgcn_mfma_f32_32x32x16_bf16(__builtin_bit_cast(bf16x8, pw1), ATT_PK(1), o[d0], 0, 0, 0);
              o[d0] = __builtin_amdgcn_mfma_f32_32x32x16_bf16(__builtin_bit_cast(bf16x8, pw2), ATT_PK(2), o[d0], 0, 0, 0);
              o[d0] = __builtin_amdgcn_mfma_f32_32x32x16_bf16(__builtin_bit_cast(bf16x8, pw3), ATT_PK(3), o[d0], 0, 0, 0);
#undef ATT_PK
          } }
        ATT_WAIT_BAR();
    }
    l = x32_sum(l);
    if (A.sink) l += __builtin_amdgcn_exp2f(A.sink[hq] * LOG2E - mhat);
    if (hi == 0) wsf[32 + r32] = l;
    asm volatile("s_waitcnt lgkmcnt(0)" ::: "memory");
    LAS bf16* stg = (LAS bf16*)(shm + L_OST) + wid * 2048;
#pragma unroll
    for (int g4 = 0; g4 < 4; ++g4) { const f32x4 lv = *(const LAS f32x4*)(wsf + 32 + 8 * g4 + 4 * hi);
#pragma unroll
        for (int j = 0; j < 4; ++j) { const int r = 4 * g4 + j; const float rl = __builtin_amdgcn_rcpf(lv[j]); const int orow = 8 * g4 + 4 * hi + j;
            stg[orow * 64 + r32] = (bf16)f2bf(o[0][r] * rl); stg[orow * 64 + 32 + r32] = (bf16)f2bf(o[1][r] * rl); } }
    asm volatile("s_waitcnt lgkmcnt(0)" ::: "memory");
#pragma unroll
    for (int i = 0; i < 4; ++i) { const int row = i * 8 + (lane >> 3), ch = lane & 7;
        const u32x4 ov = *(const LAS u32x4*)(stg + row * 64 + ch * 8);
        const size_t off = (size_t)(qrow + row) * D + hq * 64 + ch * 8;
        const u32x4 gv = *(const u32x4*)(A.SG + off);
        u32x4 w; w.x = pk2(bflo(ov.x) * bflo(gv.x), bfhi(ov.x) * bfhi(gv.x)); w.y = pk2(bflo(ov.y) * bflo(gv.y), bfhi(ov.y) * bfhi(gv.y));
        w.z = pk2(bflo(ov.z) * bflo(gv.z), bfhi(ov.z) * bfhi(gv.z)); w.w = pk2(bflo(ov.w) * bflo(gv.w), bfhi(ov.w) * bfhi(gv.w));
        *(u32x4*)(A.O + off) = w; }
    asm volatile("s_waitcnt lgkmcnt(0)" ::: "memory");
#undef ATT_PHYS
#undef ATT_ISSUE
}

__device__ __forceinline__ void attn_phase(int wid_s, int kind, int j, int bx, int G, LAS unsigned char* shm) {
    const int wid = slaunder(wid_s), lane = lane_id();
    unsigned char* ws = WSP();
    ALayer A;
    A.Q = (const bf16*)(ws + WS_Q); A.Qr = (const bf16*)(ws + WS_QR); A.SG = (const bf16*)(ws + WS_SG); A.O = (bf16*)(ws + WS_H);
    if (kind == 0) { A.K = (const bf16*)(ws + WS_KALL); A.Kr = (const bf16*)(ws + WS_KPEA) + (size_t)j * LALL * 32; A.V = (const bf16*)(ws + WS_VALL); A.kpitch = 1024; A.sink = nullptr; }
    else { A.K = (const bf16*)(ws + WS_GK) + (size_t)(kind - 1) * LALL * 256; A.Kr = A.K; A.V = (const bf16*)(ws + WS_GV) + (size_t)(kind - 1) * LALL * 256; A.kpitch = 256; A.sink = kind == 2 ? INP(I_SINK) : nullptr; }
    const int vcu = (G % 8 == 0) ? (bx % 8) * (G / 8) + bx / 8 : bx;
    const int nlat = 256, nctx = 512;
    for (int c = vcu; c < nlat + nctx / 2; c += G) {
        for (int i = 0; i < 3; ++i) {
            AUnit U; U.jump = 0; U.swa = 0; U.qpos0 = 0;
            if (i == 0) {
                if (c >= nlat) continue;
                const int b = c >> 6;
                if (kind == 0) { const int h = (c >> 2) & 15, qb = c & 3; U.qrow0 = NCTX + b * 1024 + 256 * qb; U.hq0 = h; U.gqa = 0; U.ntiles = 24; }
                else { const int kvh = (c >> 4) & 3, qb = c & 15; U.qrow0 = NCTX + b * 1024 + 64 * qb; U.hq0 = 4 * kvh; U.gqa = 1; U.ntiles = 24;
                    if (kind == 2) { const int wsb = qb - 2 < 0 ? 0 : qb - 2, web = qb + 2 > 15 ? 15 : qb + 2; U.ntiles = 8 + (web - wsb + 1); U.jump = wsb; U.swa = 1; U.qpos0 = 64 * qb; } }
                U.krow0 = NCTX + b * 1536;
            } else {
                const int u = 2 * c + (i - 1); if (c >= nlat || u >= nctx) continue;
                const int b = u >> 4;
                if (kind == 0) { U.qrow0 = b * 256; U.hq0 = u & 15; U.gqa = 0; }
                else { const int kvh = (u >> 2) & 3, qb = u & 3; U.qrow0 = b * 256 + 64 * qb; U.hq0 = 4 * kvh; U.gqa = 1; }
                U.krow0 = b * 256; U.ntiles = 4;
            }
            if (kind == 0) attn_unit<6>(A, U, shm, wid, lane); else attn_unit<4>(A, U, shm, wid, lane);
        }
    }
}
}

typedef __attribute__((address_space(1))) unsigned gu32;
#define XB_TMO      128
#define XB_XCNT(j)  (256  + 64 * (j))
#define XB_XSUB(j)  (1280 + 64 * (j))
#define XB_XGEN(j)  (2304 + 64 * (j))
#define XB_TOP      3328
#define XB_TOPGEN   3392
#define XCD_BAR_WORDS 3456
#define XB_SPIN_CAP (1u << 18)
__device__ __forceinline__ unsigned xb_ld(unsigned* p)              { return __hip_atomic_load(p, __ATOMIC_RELAXED, __HIP_MEMORY_SCOPE_AGENT); }
__device__ __forceinline__ unsigned xb_add(unsigned* p, unsigned v) { return __hip_atomic_fetch_add(p, v, __ATOMIC_RELAXED, __HIP_MEMORY_SCOPE_AGENT); }
__device__ __forceinline__ unsigned xb_xcc_id() { return (unsigned)__builtin_amdgcn_s_getreg((3 << 11) | 20) & 0xFu; }
#define XB_SPIN(cond, bar) do { unsigned _sp = 0; while (cond) { __builtin_amdgcn_s_sleep(1); \
    if ((++_sp & 255u) == 0u) { if (xb_ld(&(bar)[XB_TMO])) break; if (_sp > XB_SPIN_CAP) { atomicAdd(&(bar)[XB_TMO], 1u); break; } } } } while (0)
struct XcdBarrier { unsigned* bar; unsigned x; volatile LAS unsigned* st; };
__device__ __forceinline__ XcdBarrier xcd_barrier_post(unsigned* bar, volatile LAS unsigned* st) {
    XcdBarrier b; b.bar = bar; b.x = xb_xcc_id(); b.st = st;
    if (threadIdx.x == 0) (void)xb_add(&bar[XB_XCNT(b.x)], 1u);
    return b;
}
__device__ __forceinline__ void xcd_barrier_complete(unsigned* bar, unsigned x, unsigned& nloc, unsigned& nx) {
    const unsigned G = gridDim.x * gridDim.y * gridDim.z;
    unsigned sum, cnt, mine, sp = 0u;
    for (;;) {
        sum = 0u; cnt = 0u; mine = 0u;
#pragma unroll
        for (unsigned j = 0; j < 16; ++j) { const unsigned c = xb_ld(&bar[XB_XCNT(j)]); sum += c; cnt += (c > 0u) ? 1u : 0u; mine = (j == x) ? c : mine; }
        if (sum == G) break;
        __builtin_amdgcn_s_sleep(1);
        if ((++sp & 255u) == 0u) { if (xb_ld(&bar[XB_TMO])) break; if (sp > XB_SPIN_CAP) { atomicAdd(&bar[XB_TMO], 1u); break; } }
    }
    nloc = mine > 0u ? mine : 1u; nx = cnt > 0u ? cnt : 1u;
}
__device__ __forceinline__ void xcd_barrier(const XcdBarrier& b) {
    asm volatile("s_waitcnt vmcnt(0)" ::: "memory");
    __syncthreads();
    if (threadIdx.x == 0) {
        unsigned* bar = b.bar;
        __builtin_amdgcn_s_waitcnt(0);
        unsigned nloc = b.st[0], nx = b.st[1];
        if (nloc == 0u) { xcd_barrier_complete(bar, b.x, nloc, nx); b.st[0] = nloc; b.st[1] = nx; }
        const unsigned old = xb_add(&bar[XB_XSUB(b.x)], 1u);
        const unsigned gen = old / nloc;
        if (old + 1u == (gen + 1u) * nloc) {
            __builtin_amdgcn_fence(__ATOMIC_RELEASE, "agent");
            asm volatile("s_waitcnt vmcnt(0)" ::: "memory");
            const unsigned og = xb_add(&bar[XB_TOP], 1u);
            const unsigned tg = og / nx;
            if (og + 1u == (tg + 1u) * nx) xb_add(&bar[XB_TOPGEN], 1u);
            else XB_SPIN(xb_ld(&bar[XB_TOPGEN]) == tg, bar);
            __builtin_amdgcn_fence(__ATOMIC_ACQUIRE, "agent");
            xb_add(&bar[XB_XGEN(b.x)], 1u);
            asm volatile("s_waitcnt vmcnt(0)" ::: "memory");
        } else {
            XB_SPIN(xb_ld(&bar[XB_XGEN(b.x)]) == gen, bar);
            __builtin_amdgcn_fence(__ATOMIC_ACQUIRE, "agent");
            asm volatile("s_waitcnt vmcnt(0)" ::: "memory");
        }
    }
    __syncthreads();
}

constexpr int N_PHASES = 22;
constexpr int RING_BYTES = 131072, MISC_OFF = RING_BYTES, LDS_BYTES = 147456;
__host__ __device__ inline bool phase_empty(int ph) { if (ph == 0 || ph == 21) return false; const int L = (ph - 1) / 5, s = (ph - 1) % 5; return s == 2 && (L % 3) != 0; }
struct KArgs { Params P; int ph_lo, ph_hi, use_bar, pad; };
constexpr int KA_PHLO = 8 * (N_IN + 2), KA_PHHI = KA_PHLO + 4, KA_USEBAR = KA_PHLO + 8;
__device__ __forceinline__ int KARG_I(int off) { return *(const int __attribute__((address_space(4)))*)(KARG() + off); }

__global__ void __launch_bounds__(512, 2) mk_fwd(KArgs args) {
    extern __shared__ __attribute__((aligned(16))) unsigned char lds_raw[];
    LAS unsigned char* lds = (LAS unsigned char*)lds_raw;
    const int wid_s = __builtin_amdgcn_readfirstlane(threadIdx.x >> 6);
    {
        volatile LAS unsigned* MISC = (volatile LAS unsigned*)(lds + MISC_OFF);
        if (threadIdx.x < 64) MISC[threadIdx.x] = 0u;
        __syncthreads();
        if (KARG_I(KA_USEBAR)) (void)xcd_barrier_post((unsigned*)(WSP() + WS_CTL) + 4096, MISC + 8);
    }
    bool first = true;
    for (int ph = KARG_I(KA_PHLO); ph < KARG_I(KA_PHHI); ++ph) {
        if (phase_empty(ph)) continue;
        if (!first && KARG_I(KA_USEBAR)) { XcdBarrier bar; bar.bar = (unsigned*)(WSP() + WS_CTL) + 4096; bar.x = xb_xcc_id(); bar.st = (volatile LAS unsigned*)(lds + MISC_OFF) + 8; xcd_barrier(bar); }
        first = false;
        const int G = gridDim.x, bx = blockIdx.x;
        if (ph == 0) { p0_phase(wid_s, bx, G, lds); continue; }
        if (ph == 21) { final_phase(wid_s, bx, G); continue; }
        const int layer = (ph - 1) / 5, st = (ph - 1) % 5, kind = layer % 3, j = layer / 3;
        if (st == 0) { norm_phase(wid_s, layer, bx, G); continue; }
        if (st == 1) {
            if (kind == 0) {
                EpiMlaIn e1{j};
                pg8::Gemm g{(const bf16*)(WSP() + WS_H), (const bf16*)(WSP() + WS_WMIN) + (size_t)j * 1792 * 1024, 0};
                pg8::StaticOrder S; S.init(MTOK, 1792, G, bx);
                pg8::gemm_phase<1024, false>(wid_s, lds, g, S, e1);
            } else {
                EpiGqaIn e1{kind};
                pg8::Gemm g{(const bf16*)(WSP() + WS_H), (const bf16*)(WSP() + (kind == 1 ? WS_WGIN : WS_WSIN)), 0};
                pg8::StaticOrder S; S.init(MTOK, 2560, G, bx);
                pg8::gemm_phase<1024, false>(wid_s, lds, g, S, e1);
            }
            continue;
        }
        if (st == 2) {
            { EpiMlaUq e2{0};
              pg8::Gemm g{(const bf16*)(WSP() + WS_CQ), (const bf16*)(WSP() + WS_WUQ) + (size_t)j * 1536 * 384, 0};
              pg8::StaticOrder S; S.init(MTOK, 1536, G, bx);
              pg8::gemm_phase<384, false>(wid_s, lds, g, S, e2); }
            { EpiMlaUkv e3{0};
              pg8::Gemm g{(const bf16*)(WSP() + WS_CKVA) + (size_t)j * LALL * 256, (const bf16*)(WSP() + WS_WUKVG) + (size_t)j * 2048 * 256, (long)(WS_WUKVP - WS_WUKVG)};
              pg8::StaticOrder S; S.init(LALL, 2048, G, G - 1 - bx);
              pg8::gemm_phase<256, true>(wid_s, lds, g, S, e3); }
            ckvfix_phase(wid_s, j, bx, G);
            continue;
        }
        if (st == 3) { att::attn_phase(wid_s, kind, j, bx, G, lds); continue; }
        {
            EpiOut eo{layer};
            pg8::Gemm g{(const bf16*)(WSP() + WS_H), (const bf16*)(WSP() + WS_WOUT) + (size_t)layer * 1024 * 1024, 0};
            pg8::StaticOrder S; S.init(MTOK, 1024, G, bx);
            pg8::gemm_phase<1024, false>(wid_s, lds, g, S, eo);
        }
    }
}

#ifndef MK_ONE_LAUNCH
#define MK_ONE_LAUNCH 1
#endif
extern "C" void kernel_launch(void* const* d_in, const int* in_sizes, int n_in, void* d_out, int out_size, void* d_ws, size_t ws_size, hipStream_t stream) {
    static int grid = 0;
    if (grid == 0) {
        if (n_in != N_IN || ws_size < WS_END || out_size != 25690112) { fprintf(stderr, "kernel_launch: unexpected shapes n_in %d ws %zu out %d\n", n_in, ws_size, out_size); grid = -1; return; }
        int dev = 0, cus = 0;
        if (hipGetDevice(&dev) != hipSuccess || hipDeviceGetAttribute(&cus, hipDeviceAttributeMultiprocessorCount, dev) != hipSuccess) { grid = -1; return; }
        if (hipFuncSetAttribute((const void*)mk_fwd, hipFuncAttributeMaxDynamicSharedMemorySize, LDS_BYTES) != hipSuccess) { fprintf(stderr, "kernel_launch: hipFuncSetAttribute failed\n"); grid = -1; return; }
        grid = cus;
    }
    if (grid < 0) return;
    (void)hipMemsetAsync((char*)d_ws + WS_CTL, 0, CTL_BYTES, stream);
    KArgs a{};
    for (int i = 0; i < N_IN; ++i) a.P.in[i] = (const float*)d_in[i];
    a.P.out = (float*)d_out; a.P.ws = (unsigned char*)d_ws;
#if MK_ONE_LAUNCH
    a.ph_lo = 0; a.ph_hi = N_PHASES; a.use_bar = 1;
    hipLaunchKernelGGL(mk_fwd, dim3(grid), dim3(512), LDS_BYTES, stream, a);
#else
    for (int ph = 0; ph < N_PHASES; ++ph) {
        if (phase_empty(ph)) continue;
        a.ph_lo = ph; a.ph_hi = ph + 1; a.use_bar = 0;
        hipLaunchKernelGGL(mk_fwd, dim3(grid), dim3(512), LDS_BYTES, stream, a);
    }
#endif
}
```
